# Optimizing an MI355X kernel written in HIP

```python
import math
import jax, jax.numpy as jnp
from jax import lax
import numpy as np

D_MODEL = 1024
BATCH = 2
SEQ = 8192
DEPTH = 4
DEC_BATCH = 128
DEC_SEQ = 4
PAST_LEN = 8192
PAGE_SIZE = 128

N_EVEN = (DEPTH + 1) // 2
N_ODD = DEPTH // 2
NORM_EPS = 1e-6
NEG_INF = -1e30

SWA_HEADS = 8
SWA_KV_HEADS = 2
SWA_HEAD_DIM = 64
SWA_GROUP = SWA_HEADS // SWA_KV_HEADS
SWA_WIDTH = SWA_HEADS * SWA_HEAD_DIM
SWA_KV_WIDTH = SWA_KV_HEADS * SWA_HEAD_DIM
WINDOW = 128
SWA_BLOCK = WINDOW
REL_BUCKETS = 32
REL_MAX_DIST = 128

GMLP_GROUPS = 4
GMLP_CHUNK = 128
GMLP_WIDTH = D_MODEL // 2
GMLP_GROUP_DIM = GMLP_WIDTH // GMLP_GROUPS

EVEN_SIZES = (SWA_WIDTH, SWA_KV_WIDTH, SWA_KV_WIDTH, SWA_WIDTH, GMLP_WIDTH, GMLP_WIDTH, GMLP_WIDTH)
EVEN_IN = 3 * SWA_WIDTH // 1 - SWA_WIDTH + 2 * SWA_KV_WIDTH + 3 * GMLP_WIDTH
EVEN_MIX = SWA_WIDTH + GMLP_WIDTH

RET_HEADS = D_MODEL // 256
RET_KEY_DIM = 256
RET_VALUE_DIM = 2 * RET_KEY_DIM
RET_QK_WIDTH = RET_HEADS * RET_KEY_DIM
RET_V_WIDTH = RET_HEADS * RET_VALUE_DIM
RET_CHUNK = 128
ODD_SIZES = (RET_QK_WIDTH, RET_QK_WIDTH, RET_V_WIDTH, RET_V_WIDTH)
ODD_IN = 2 * RET_QK_WIDTH + 2 * RET_V_WIDTH

kernel_name = "hybrid_swa_gmlp_retention_step"


def _split(z, sizes):
    out, start = [], 0
    for s in sizes:
        out.append(z[..., start:start + s])
        start += s
    return out


def rmsnorm(x, g):
    x32 = x.astype(jnp.float32)
    y = x32 * lax.rsqrt(jnp.mean(x32 * x32, axis=-1, keepdims=True) + NORM_EPS)
    return (y * g.astype(jnp.float32)).astype(x.dtype)


def t5_bucket(dist):
    n = jnp.maximum(dist, 0)
    max_exact = REL_BUCKETS // 2
    nf = jnp.maximum(n, 1).astype(jnp.float32)
    large = max_exact + (jnp.log(nf / max_exact) / math.log(REL_MAX_DIST / max_exact)
                         * (REL_BUCKETS - max_exact)).astype(jnp.int32)
    large = jnp.minimum(large, REL_BUCKETS - 1)
    return jnp.where(n < max_exact, n, large)


def rel_bias(dist, table):
    b = table[t5_bucket(dist)].astype(jnp.float32)
    b = jnp.moveaxis(b, -1, 0)
    return b.reshape(SWA_KV_HEADS, SWA_GROUP, *dist.shape)


def sink_softmax(scores, sink):
    sink = sink.astype(jnp.float32)
    m = jnp.maximum(scores.max(axis=-1, keepdims=True), sink)
    p = jnp.exp(scores - m)
    return p / (p.sum(axis=-1, keepdims=True) + jnp.exp(sink - m))


def swa_prompt(q, k, v, sinks, table):
    B, S = q.shape[:2]
    nb = S // SWA_BLOCK
    qb = q.reshape(B, nb, SWA_BLOCK, SWA_KV_HEADS, SWA_GROUP, SWA_HEAD_DIM)
    kb = k.reshape(B, nb, SWA_BLOCK, SWA_KV_HEADS, SWA_HEAD_DIM)
    vb = v.reshape(B, nb, SWA_BLOCK, SWA_KV_HEADS, SWA_HEAD_DIM)
    shift = lambda a: jnp.concatenate([jnp.zeros_like(a[:, :1]), a[:, :-1]], axis=1)
    kk = jnp.concatenate([shift(kb), kb], axis=2)
    vv = jnp.concatenate([shift(vb), vb], axis=2)
    scores = jnp.einsum('bnqkgd,bnskd->bnkgqs', qb, kk).astype(jnp.float32) * (SWA_HEAD_DIM ** -0.5)
    qi = jnp.arange(SWA_BLOCK)[:, None]
    sj = jnp.arange(2 * SWA_BLOCK)[None, :]
    dist = qi + SWA_BLOCK - sj
    kpos = jnp.arange(nb)[:, None, None] * SWA_BLOCK - SWA_BLOCK + sj[None]
    valid = (dist >= 0) & (dist < WINDOW) & (kpos >= 0)
    bias = rel_bias(dist, table)
    scores = jnp.where(valid[None, :, None, None], scores + bias[None, None], NEG_INF)
    sink = sinks.reshape(SWA_KV_HEADS, SWA_GROUP)[None, None, :, :, None, None]
    probs = sink_softmax(scores, sink)
    out = jnp.einsum('bnkgqs,bnskd->bnqkgd', probs.astype(v.dtype), vv)
    return out.reshape(B, S, SWA_WIDTH)


def swa_sample(q, k, v, cache_k, cache_v, sinks, table):
    DB, T = q.shape[:2]
    kk = jnp.concatenate([cache_k.astype(k.dtype), k], axis=1)
    vv = jnp.concatenate([cache_v.astype(v.dtype), v], axis=1)
    scores = jnp.einsum('btkgd,bskd->bkgts', q, kk).astype(jnp.float32) * (SWA_HEAD_DIM ** -0.5)
    dist = jnp.arange(T)[:, None] + WINDOW - jnp.arange(WINDOW + T)[None, :]
    valid = (dist >= 0) & (dist < WINDOW)
    bias = rel_bias(dist, table)
    scores = jnp.where(valid, scores + bias[None], NEG_INF)
    sink = sinks.reshape(SWA_KV_HEADS, SWA_GROUP)[None, :, :, None, None]
    probs = sink_softmax(scores, sink)
    out = jnp.einsum('bkgts,bskd->btkgd', probs.astype(v.dtype), vv)
    return out.reshape(DB, T, SWA_WIDTH), kk[:, -WINDOW:], vv[:, -WINDOW:]


def gmlp_spatial(u, vb, ws, bs, ln_gain):
    B, T = u.shape[:2]
    L = min(T, GMLP_CHUNK)
    nc = T // L
    v32 = vb.astype(jnp.float32)
    mu = jnp.mean(v32, axis=-1, keepdims=True)
    var = jnp.mean(jnp.square(v32 - mu), axis=-1, keepdims=True)
    vn = ((v32 - mu) * lax.rsqrt(var + NORM_EPS) * ln_gain.astype(jnp.float32)).astype(u.dtype)
    vc = vn.reshape(B, nc, L, GMLP_GROUPS, GMLP_GROUP_DIM)
    wm = jnp.tril(ws[:, :L, :L]).astype(vc.dtype)
    s = jnp.einsum('gpq,bnqgc->bnpgc', wm, vc) + bs[:, :L].T[None, None, :, :, None]
    return u * s.reshape(B, T, GMLP_WIDTH), vn


def even_layer(x, g_norm, w_in, w_out, sinks, table, ws, bs, ln_gain, cache_k, cache_v):
    B, T = x.shape[:2]
    z = rmsnorm(x, g_norm) @ w_in
    q, k, v, ga, u, vb, gb = _split(z, EVEN_SIZES)
    q = q.reshape(B, T, SWA_KV_HEADS, SWA_GROUP, SWA_HEAD_DIM)
    k = k.reshape(B, T, SWA_KV_HEADS, SWA_HEAD_DIM)
    v = v.reshape(B, T, SWA_KV_HEADS, SWA_HEAD_DIM)
    if cache_k is None:
        attn = swa_prompt(q, k, v, sinks, table)
        new_k, new_v = k[:, -WINDOW:], v[:, -WINDOW:]
    else:
        attn, new_k, new_v = swa_sample(q, k, v, cache_k, cache_v, sinks, table)
    sg, vn = gmlp_spatial(u, vb, ws, bs, ln_gain)
    mix = jnp.concatenate([jax.nn.silu(ga) * attn.astype(x.dtype), jax.nn.silu(gb) * sg], axis=-1)
    return x + mix @ w_out, new_k, new_v, vn


def xpos_rotate(x, pos):
    angle = 1.0 / (10000.0 ** jnp.linspace(0.0, 1.0, RET_KEY_DIM // 2, dtype=jnp.float32))
    ang = pos.astype(jnp.float32)[:, None] * angle[None, :]
    sin = jnp.sin(ang)[:, None, :]
    cos = jnp.cos(ang)[:, None, :]
    x32 = x.astype(jnp.float32)
    x0, x1 = x32[..., 0::2], x32[..., 1::2]
    return jnp.stack([x0 * cos - x1 * sin, x1 * cos + x0 * sin], axis=-1).reshape(x.shape)


def retention_scan(q, k, v, S0, chunk):
    B, T, H, _ = q.shape
    nc = T // chunk
    lg = jnp.log(1.0 - 2.0 ** (-5.0 - jnp.arange(RET_HEADS, dtype=jnp.float32)))
    idx = jnp.arange(chunk, dtype=jnp.float32)
    diff = idx[:, None] - idx[None, :]
    decay = jnp.where(diff >= 0, jnp.exp(lg[:, None, None] * jnp.maximum(diff, 0.0)), 0.0)
    q_dec = jnp.exp(lg[None, :] * (idx[:, None] + 1.0))
    k_dec = jnp.exp(lg[None, :] * (chunk - 1.0 - idx)[:, None])
    c_dec = jnp.exp(lg * chunk)

    def step(S, inp):
        qc, kc, vc = inp
        att = jnp.einsum('bihd,bjhd->bhij', qc, kc) * decay
        intra = jnp.einsum('bhij,bjhe->bihe', att, vc)
        cross = jnp.einsum('bihd,bhde->bihe', qc, S) * q_dec[None, :, :, None]
        S = c_dec[None, :, None, None] * S + jnp.einsum('bjhd,bjhe->bhde', kc * k_dec[None, :, :, None], vc)
        return S, intra + cross

    blk = lambda a: a.reshape(B, nc, chunk, H, a.shape[-1]).swapaxes(0, 1)
    S, o = lax.scan(step, S0, (blk(q), blk(k), blk(v)))
    return o.swapaxes(0, 1).reshape(B, T, H, RET_VALUE_DIM), S


def odd_layer(x, g_norm, w_in, w_out, S0, pos0):
    B, T = x.shape[:2]
    z = rmsnorm(x, g_norm) @ w_in
    q, k, v, g = _split(z, ODD_SIZES)
    pos = pos0 + jnp.arange(T, dtype=jnp.int32)
    q = xpos_rotate(q.reshape(B, T, RET_HEADS, RET_KEY_DIM), pos)
    k = xpos_rotate(k.reshape(B, T, RET_HEADS, RET_KEY_DIM), pos) * (RET_KEY_DIM ** -0.5)
    v = v.reshape(B, T, RET_HEADS, RET_VALUE_DIM).astype(jnp.float32)
    o, S = retention_scan(q, k, v, S0.astype(jnp.float32), min(T, RET_CHUNK))
    mu = jnp.mean(o, axis=-1, keepdims=True)
    var = jnp.mean(jnp.square(o - mu), axis=-1, keepdims=True)
    o = ((o - mu) * lax.rsqrt(var + NORM_EPS)).reshape(B, T, RET_V_WIDTH).astype(x.dtype)
    return x + (jax.nn.silu(g) * o) @ w_out, S


def setup_inputs(seed: int = 0) -> dict:
    key = jax.random.key(seed)
    ks = jax.random.split(key, 18)
    f32 = jnp.float32
    nrm = lambda k, shape, s: jax.random.normal(k, shape, f32) * s
    resid = (2.0 * DEPTH) ** -0.5
    return {
        'x_prompt': nrm(ks[0], (BATCH, SEQ, D_MODEL), 1.0),
        'x_sample': nrm(ks[1], (DEC_BATCH, DEC_SEQ, D_MODEL), 1.0),
        'cache_swa_k': nrm(ks[2], (N_EVEN, DEC_BATCH, WINDOW, SWA_KV_HEADS, SWA_HEAD_DIM), 1.0),
        'cache_swa_v': nrm(ks[3], (N_EVEN, DEC_BATCH, WINDOW, SWA_KV_HEADS, SWA_HEAD_DIM), 1.0),
        'state_ret': nrm(ks[4], (N_ODD, DEC_BATCH, RET_HEADS, RET_KEY_DIM, RET_VALUE_DIM), 0.3),
        'norm_gain': 1.0 + nrm(ks[5], (DEPTH, D_MODEL), 0.05),
        'final_norm_gain': 1.0 + nrm(ks[6], (D_MODEL,), 0.05),
        'rel_bias_table': nrm(ks[7], (REL_BUCKETS, SWA_HEADS), 0.5),
        'even_w_in': nrm(ks[8], (N_EVEN, D_MODEL, EVEN_IN), D_MODEL ** -0.5),
        'even_w_out': nrm(ks[9], (N_EVEN, EVEN_MIX, D_MODEL), EVEN_MIX ** -0.5 * resid),
        'swa_sinks': nrm(ks[10], (N_EVEN, SWA_HEADS), 1.0),
        'gmlp_ws': nrm(ks[11], (N_EVEN, GMLP_GROUPS, GMLP_CHUNK, GMLP_CHUNK), GMLP_CHUNK ** -0.5),
        'gmlp_bs': 1.0 + nrm(ks[12], (N_EVEN, GMLP_GROUPS, GMLP_CHUNK), 0.1),
        'gmlp_ln_gain': 1.0 + nrm(ks[13], (N_EVEN, GMLP_WIDTH), 0.05),
        'odd_w_in': nrm(ks[14], (N_ODD, D_MODEL, ODD_IN), D_MODEL ** -0.5),
        'odd_w_out': nrm(ks[15], (N_ODD, RET_V_WIDTH, D_MODEL), RET_V_WIDTH ** -0.5 * resid),
    }


def reference(x_prompt, x_sample, cache_swa_k, cache_swa_v, state_ret, norm_gain, final_norm_gain,
              rel_bias_table, even_w_in, even_w_out, swa_sinks, gmlp_ws, gmlp_bs, gmlp_ln_gain,
              odd_w_in, odd_w_out):
    yp, ys = x_prompt, x_sample
    kp_l, vp_l, ks_l, vs_l, sp_l, ss_l, gv_l = [], [], [], [], [], [], []
    for layer in range(DEPTH):
        if layer % 2 == 0:
            e = layer // 2
            yp, kp, vp, _ = even_layer(yp, norm_gain[layer], even_w_in[e], even_w_out[e], swa_sinks[e],
                                       rel_bias_table, gmlp_ws[e], gmlp_bs[e], gmlp_ln_gain[e], None, None)
            ys, kn, vn_, gv = even_layer(ys, norm_gain[layer], even_w_in[e], even_w_out[e], swa_sinks[e],
                                         rel_bias_table, gmlp_ws[e], gmlp_bs[e], gmlp_ln_gain[e],
                                         cache_swa_k[e], cache_swa_v[e])
            kp_l.append(kp); vp_l.append(vp); ks_l.append(kn); vs_l.append(vn_); gv_l.append(gv)
        else:
            o = layer // 2
            S0 = jnp.zeros((yp.shape[0], RET_HEADS, RET_KEY_DIM, RET_VALUE_DIM), jnp.float32)
            yp, sp = odd_layer(yp, norm_gain[layer], odd_w_in[o], odd_w_out[o], S0, 0)
            ys, ss = odd_layer(ys, norm_gain[layer], odd_w_in[o], odd_w_out[o], state_ret[o], PAST_LEN)
            sp_l.append(sp); ss_l.append(ss)
    y_prompt = rmsnorm(yp, final_norm_gain)
    y_sample = rmsnorm(ys, final_norm_gain)
    return (y_prompt, y_sample, jnp.stack(kp_l), jnp.stack(vp_l), jnp.stack(ks_l), jnp.stack(vs_l),
            jnp.stack(sp_l), jnp.stack(ss_l), jnp.stack(gv_l))
```

```cpp
#include <hip/hip_runtime.h>
#include <cstdio>
#include <cstdint>

#ifndef MK_ONE_LAUNCH
#define MK_ONE_LAUNCH 1
#endif

#define GAS __attribute__((address_space(1)))
#define LAS __attribute__((address_space(3)))
typedef unsigned short bf16;
typedef short bf16x8 __attribute__((ext_vector_type(8)));
typedef short s16x4 __attribute__((ext_vector_type(4)));
typedef float f32x4 __attribute__((ext_vector_type(4)));
typedef float f32x2 __attribute__((ext_vector_type(2)));
typedef unsigned u32x4 __attribute__((ext_vector_type(4)));
typedef unsigned u32x2 __attribute__((ext_vector_type(2)));

constexpr int DM = 1024, SEQ = 8192, NB = 2, DB = 128, DT = 4, WIN = 128;
constexpr int MP = NB * SEQ;
constexpr int MS = DB * DT;
constexpr int M = MP + MS;
constexpr int EVEN_IN = 2816, ODD_IN = 6144;
constexpr float EPS = 1e-6f;
constexpr int NPOS = SEQ + DT;

constexpr size_t O_Y = 0;
constexpr size_t O_KP = (size_t)M * DM;
constexpr size_t O_VP = O_KP + 2 * 2 * 128 * 128;
constexpr size_t O_KS = O_VP + 2 * 2 * 128 * 128;
constexpr size_t O_VS = O_KS + (size_t)2 * 128 * 128 * 128;
constexpr size_t O_RP = O_VS + (size_t)2 * 128 * 128 * 128;
constexpr size_t O_RS = O_RP + (size_t)2 * 2 * 4 * 256 * 512;
constexpr size_t O_GV = O_RS + (size_t)2 * 128 * 4 * 256 * 512;
constexpr size_t O_END = O_GV + (size_t)2 * 128 * 4 * 512;

constexpr size_t MiB = 1u << 20;
constexpr size_t WS_CTL = 0, CTL_ZERO_BYTES = 1 * MiB;
constexpr size_t WS_SS = 256 * 1024;
constexpr size_t WS_TAB = 1 * MiB;
constexpr size_t TAB_RELB = 0;
constexpr size_t TAB_GP = 4096;
constexpr size_t TAB_WS16 = 8192;
constexpr size_t WS_SINCOS = 2 * MiB;
constexpr size_t WS_WINE = 11 * MiB;
constexpr size_t WS_WOUTE = 23 * MiB;
constexpr size_t WS_WINO = 27 * MiB;
constexpr size_t WS_WOUTO = 51 * MiB;
constexpr size_t WS_XB = 60 * MiB;
constexpr size_t WS_Z = 94 * MiB;
constexpr size_t WS_MIX = 326 * MiB;
constexpr size_t WS_OB = 393 * MiB;
constexpr size_t WS_ATT = 460 * MiB;
constexpr size_t WS_END = 477 * MiB;
constexpr size_t ZE_ZN = 0;
constexpr size_t ZE_KN = (size_t)M * 2048 * 2;
constexpr size_t ZE_VT = ZE_KN + (size_t)M * 128 * 2;
constexpr size_t ZE_VBT = ZE_VT + (size_t)M * 128 * 2;
constexpr size_t ZO_QN = 0;
constexpr size_t ZO_KN = (size_t)M * 1024 * 2;
constexpr size_t ZO_KT = ZO_KN + (size_t)M * 1024 * 2;
constexpr size_t ZO_VT = ZO_KT + (size_t)M * 1024 * 2;
constexpr size_t ZO_GN = ZO_VT + (size_t)M * 2048 * 2;
static_assert(ZO_GN + (size_t)M * 2048 * 2 <= WS_MIX - WS_Z, "z region");
static_assert(ZE_VBT + (size_t)M * 512 * 2 <= WS_MIX - WS_Z, "z region");

__device__ __forceinline__ unsigned cvt_pk_bf16(float lo, float hi) { unsigned r; asm volatile("v_cvt_pk_bf16_f32 %0, %1, %2" : "=v"(r) : "v"(lo), "v"(hi)); return r; }
__device__ __forceinline__ float bf2f(unsigned short b) { return __uint_as_float(((unsigned)b) << 16); }
__device__ __forceinline__ float bflo(unsigned w) { return __uint_as_float(w << 16); }
__device__ __forceinline__ float bfhi(unsigned w) { return __uint_as_float(w & 0xffff0000u); }
__device__ __forceinline__ unsigned short f2bf(float f) { return (unsigned short)(cvt_pk_bf16(f, 0.f) & 0xffffu); }
__device__ __forceinline__ float silu_f(float x) { return x * __builtin_amdgcn_rcpf(1.0f + __expf(-x)); }
__device__ __forceinline__ float wave_sum(float v) {
#pragma unroll
    for (int o = 1; o < 64; o <<= 1) v += __shfl_xor(v, o);
    return v;
}
__device__ __forceinline__ float wave_max(float v) {
#pragma unroll
    for (int o = 1; o < 64; o <<= 1) v = fmaxf(v, __shfl_xor(v, o));
    return v;
}
#define MFMA16(a, b, c) __builtin_amdgcn_mfma_f32_16x16x32_bf16((a), (b), (c), 0, 0, 0)

namespace pg8 {
#define PG8_LAS __attribute__((address_space(3)))
typedef unsigned short bf16_t;
constexpr int BM = 256, BK = 64, HALF = 128, HTB = HALF * BK * 2, STAGE_BYTES = 8 * HTB, NXCD = 8, WGM = 8;
__host__ __device__ __forceinline__ int lds_byte(int r, int c) { const int st = (r >> 4) * 2 + (c >> 5), rr = r & 15, cc = c & 31, ob = rr * 64 + cc * 2; return st * 1024 + (ob ^ (((ob >> 9) & 1) << 5)); }
__host__ __device__ __forceinline__ void stage_rc(int b, int& R, int& C) { const int st = b / 1024, sb = b % 1024, swz = sb ^ (((sb >> 9) & 1) << 5); R = (st >> 1) * 16 + swz / 64; C = (st & 1) * 32 + (swz % 64) / 2; }
__host__ __device__ __forceinline__ int perm32(int rho) { const int n = rho >> 4, i = rho & 15; return 8 * (i >> 2) + 4 * n + (i & 3); }

struct Unit { int pm, pn, sw; };
struct Gemm { const bf16_t* A; const bf16_t* Bt; int M, N, K; };

struct StaticOrder {
    int nM, nN, nwg, G, c; unsigned swmask;
    __host__ __device__ void init(int M_, int N_, int G_, int c_, unsigned swm) { nM = M_ / BM; nN = N_ / BM; nwg = nM * nN; G = G_; c = c_; swmask = swm; }
    __host__ __device__ bool next(int i, Unit& u) const {
        const long L = (long)i * G + c; if (L >= nwg) return false;
        int wgid = (int)L; { const int q = nwg / NXCD, r = nwg % NXCD, xcd = wgid % NXCD, off = wgid / NXCD; wgid = (xcd < r ? xcd * (q + 1) : r * (q + 1) + (xcd - r) * q) + off; }
        const int nig = WGM * nN, gid = wgid / nig, fm = gid * WGM, gsz = (nM - fm) < WGM ? (nM - fm) : WGM;
        u.pm = fm + ((wgid % nig) % gsz); u.pn = (wgid % nig) / gsz; u.sw = (int)((swmask >> u.pn) & 1u); return true;
    }
    __device__ __forceinline__ void a_ready(const Unit&) const {}
    __device__ __forceinline__ void done(const Unit&) const {}
};

template <class Epi, class Sched, bool ALIGN_EPI = false, bool SP2 = false>
__device__ __forceinline__ void gemm_phase(PG8_LAS unsigned char* lds, const Gemm g, const Sched& S, const Epi& E) {
    int tid = threadIdx.x; asm volatile("" : "+v"(tid));
    const int wid = __builtin_amdgcn_readfirstlane(tid >> 6), lane = tid & 63, wr = wid >> 2, wc = wid & 3, fr = lane & 15, fq = lane >> 4;
    const int K = g.K, nt = K / BK;
    unsigned voffA[2], voffB[2];
#pragma unroll
    for (int i = 0; i < 2; ++i) { int R, C; stage_rc(tid * 16 + i * 8192, R, C); const int Rb = Epi::PERM ? ((R & ~31) + perm32(R & 31)) : R;
        voffA[i] = (unsigned)(R * K + C) * 2u; voffB[i] = (unsigned)(Rb * K + C) * 2u; }
    const size_t kstep = (size_t)(BK * 2);
    const size_t hstep = (size_t)HALF * K * 2;
    const size_t tstep = 2 * hstep;
    const unsigned ldsw = (unsigned)wid * 1024u;
    const int aoff = lds_byte(wr * 64 + fr, fq * 8), boff = lds_byte(wc * 32 + fr, fq * 8);
#define PG8_SA(b, h) (((b) * 2 + (h)) * HTB)
#define PG8_SB(b, h) ((4 + (b) * 2 + (h)) * HTB)
#define PG8_STAGE(bufoff, gbase, voff) do { _Pragma("unroll") for (int _i = 0; _i < 2; ++_i) \
        __builtin_amdgcn_global_load_lds((const unsigned*)((const char*)(gbase) + (voff)[_i]), (PG8_LAS unsigned*)(lds + (bufoff) + ldsw + _i * 8192), 16, 0, 0); } while (0)
#define PG8_LDA(dst, b, h) do { _Pragma("unroll") for (int m = 0; m < 4; ++m) _Pragma("unroll") for (int k = 0; k < 2; ++k) dst[m][k] = *(const PG8_LAS bf16x8*)(lds + PG8_SA(b, h) + aoff + m * 2048 + k * 1024); } while (0)
#define PG8_LDB(dst, b, h) do { _Pragma("unroll") for (int n = 0; n < 2; ++n) _Pragma("unroll") for (int k = 0; k < 2; ++k) dst[n][k] = *(const PG8_LAS bf16x8*)(lds + PG8_SB(b, h) + boff + n * 2048 + k * 1024); } while (0)
#define PG8_MMA(ai, bj, At, Bt) do { __builtin_amdgcn_s_setprio(1); _Pragma("unroll") for (int m = 0; m < 4; ++m) _Pragma("unroll") for (int n = 0; n < 2; ++n) _Pragma("unroll") for (int k = 0; k < 2; ++k) \
        acc[ai][bj][m][n] = __builtin_amdgcn_mfma_f32_16x16x32_bf16(Bt[n][k], At[m][k], acc[ai][bj][m][n], 0, 0, 0); __builtin_amdgcn_s_setprio(0); } while (0)
#define PG8_WAIT_V(n) asm volatile("s_waitcnt vmcnt(" #n ")" ::: "memory")
#define PG8_WAIT_L(n) asm volatile("s_waitcnt lgkmcnt(" #n ")" ::: "memory")
#define PG8_BAR __builtin_amdgcn_s_barrier()
#define PG8_SCHED __builtin_amdgcn_sched_barrier(0)
#define PG8_UA(u) ((u).sw ? (const char*)g.Bt + (size_t)(u).pn * tstep : (const char*)g.A + (size_t)(u).pm * tstep)
#define PG8_UB(u) ((u).sw ? (const char*)g.A + (size_t)(u).pm * tstep : (const char*)g.Bt + (size_t)(u).pn * tstep)
    Unit cur, nxt; int ui = 0;
    if (!S.next(0, cur)) return;
    f32x4 acc[2][2][4][2];
#pragma unroll
    for (int a = 0; a < 2; ++a)
#pragma unroll
        for (int b = 0; b < 2; ++b)
#pragma unroll
            for (int m = 0; m < 4; ++m)
#pragma unroll
                for (int n = 0; n < 2; ++n) acc[a][b][m][n] = (f32x4){0.f, 0.f, 0.f, 0.f};
    bf16x8 At[4][2], B0[2][2], B1[2][2];
    const char* cA = PG8_UA(cur); const char* cB = PG8_UB(cur);
    S.a_ready(cur);
    if constexpr (SP2) {
        PG8_STAGE(PG8_SB(0, 0), cB, voffB); PG8_STAGE(PG8_SB(0, 1), cB + hstep, voffB); PG8_STAGE(PG8_SA(0, 0), cA, voffA); PG8_STAGE(PG8_SA(0, 1), cA + hstep, voffA);
        if (wr == 1) PG8_BAR;
        PG8_WAIT_V(2); PG8_BAR;
        PG8_STAGE(PG8_SB(1, 0), cB + kstep, voffB); PG8_STAGE(PG8_SA(1, 0), cA + kstep, voffA); PG8_STAGE(PG8_SB(1, 1), cB + hstep + kstep, voffB);
        PG8_WAIT_V(6); PG8_BAR;
    } else {
        PG8_STAGE(PG8_SB(0, 0), cB, voffB); PG8_STAGE(PG8_SA(0, 0), cA, voffA); PG8_STAGE(PG8_SB(0, 1), cB + hstep, voffB); PG8_STAGE(PG8_SA(0, 1), cA + hstep, voffA);
        if (wr == 1) PG8_BAR;
        PG8_WAIT_V(4); PG8_BAR;
        PG8_STAGE(PG8_SB(1, 0), cB + kstep, voffB); PG8_STAGE(PG8_SA(1, 0), cA + kstep, voffA); PG8_STAGE(PG8_SB(1, 1), cB + hstep + kstep, voffB);
        PG8_WAIT_V(6); PG8_BAR;
    }
    for (;;) {
        const bool has_next = S.next(ui + 1, nxt);
        const char* nA = has_next ? PG8_UA(nxt) : cA; const char* nB = has_next ? PG8_UB(nxt) : cB;
        for (int t = 0; t < nt; t += 2) {
            const bool last = (t == nt - 2);
            const char* a1 = cA + (size_t)(t + 1) * kstep;
            const char* a2 = last ? nA : cA + (size_t)(t + 2) * kstep; const char* b2 = last ? nB : cB + (size_t)(t + 2) * kstep;
            const char* a3 = a2 + kstep; const char* b3 = b2 + kstep;
            if (last && has_next) S.a_ready(nxt);
            if constexpr (SP2) {
            PG8_LDB(B0, 0, 0); PG8_LDB(B1, 0, 1); PG8_SCHED; PG8_LDA(At, 0, 0); PG8_STAGE(PG8_SA(1, 1), a1 + hstep, voffA);
            PG8_WAIT_V(8); PG8_WAIT_L(0); PG8_BAR; PG8_MMA(0, 0, At, B0); PG8_MMA(0, 1, At, B1); PG8_BAR; PG8_SCHED;
            PG8_LDA(At, 0, 1); PG8_STAGE(PG8_SB(0, 0), b2, voffB); PG8_STAGE(PG8_SB(0, 1), b2 + hstep, voffB); PG8_STAGE(PG8_SA(0, 0), a2, voffA);
            PG8_WAIT_V(8); PG8_WAIT_L(0); PG8_BAR; PG8_MMA(1, 0, At, B0); PG8_MMA(1, 1, At, B1); PG8_BAR; PG8_SCHED;
            PG8_LDB(B0, 1, 0); PG8_LDB(B1, 1, 1); PG8_SCHED; PG8_LDA(At, 1, 0); PG8_STAGE(PG8_SA(0, 1), a2 + hstep, voffA);
            PG8_WAIT_V(8); PG8_WAIT_L(0); PG8_BAR; PG8_MMA(0, 0, At, B0); PG8_MMA(0, 1, At, B1); PG8_BAR; PG8_SCHED;
            PG8_LDA(At, 1, 1); PG8_STAGE(PG8_SB(1, 0), b3, voffB); PG8_STAGE(PG8_SB(1, 1), b3 + hstep, voffB); PG8_STAGE(PG8_SA(1, 0), a3, voffA);
            PG8_WAIT_V(8); PG8_WAIT_L(0); PG8_BAR; PG8_MMA(1, 0, At, B0); PG8_MMA(1, 1, At, B1); PG8_BAR; PG8_SCHED;
            } else {
            PG8_LDB(B0, 0, 0); PG8_SCHED; PG8_LDA(At, 0, 0); PG8_STAGE(PG8_SA(1, 1), a1 + hstep, voffA);
            PG8_WAIT_L(8); PG8_BAR; PG8_WAIT_L(0); PG8_MMA(0, 0, At, B0); PG8_BAR; PG8_SCHED;
            PG8_LDB(B1, 0, 1); PG8_STAGE(PG8_SB(0, 0), b2, voffB);
            PG8_BAR; PG8_WAIT_L(0); PG8_MMA(0, 1, At, B1); PG8_BAR;
            PG8_LDA(At, 0, 1); PG8_STAGE(PG8_SA(0, 0), a2, voffA);
            PG8_BAR; PG8_WAIT_L(0); PG8_MMA(1, 0, At, B0); PG8_BAR; PG8_SCHED;
            PG8_STAGE(PG8_SB(0, 1), b2 + hstep, voffB);
            PG8_WAIT_V(6); PG8_BAR; PG8_MMA(1, 1, At, B1); PG8_BAR;
            PG8_LDB(B0, 1, 0); PG8_SCHED; PG8_LDA(At, 1, 0); PG8_STAGE(PG8_SA(0, 1), a2 + hstep, voffA);
            PG8_WAIT_L(8); PG8_BAR; PG8_WAIT_L(0); PG8_MMA(0, 0, At, B0); PG8_BAR; PG8_SCHED;
            PG8_LDB(B1, 1, 1); PG8_STAGE(PG8_SB(1, 0), b3, voffB);
            PG8_BAR; PG8_WAIT_L(0); PG8_MMA(0, 1, At, B1); PG8_BAR;
            PG8_LDA(At, 1, 1); PG8_STAGE(PG8_SA(1, 0), a3, voffA);
            PG8_BAR; PG8_WAIT_L(0); PG8_MMA(1, 0, At, B0); PG8_BAR; PG8_SCHED;
            PG8_STAGE(PG8_SB(1, 1), b3 + hstep, voffB);
            PG8_WAIT_V(6); PG8_BAR; PG8_MMA(1, 1, At, B1); PG8_BAR;
            }
        }
        if constexpr (ALIGN_EPI) { if (wr == 0) PG8_BAR; }
        E(acc, cur, wr, wc, fr, fq); S.done(cur);
        if (!has_next) break;
#pragma unroll
        for (int a = 0; a < 2; ++a)
#pragma unroll
            for (int b = 0; b < 2; ++b)
#pragma unroll
                for (int m = 0; m < 4; ++m)
#pragma unroll
                    for (int n = 0; n < 2; ++n) acc[a][b][m][n] = (f32x4){0.f, 0.f, 0.f, 0.f};
        cur = nxt; cA = nA; cB = nB; ++ui;
        if constexpr (ALIGN_EPI) { if (wr == 1) PG8_BAR; }
    }
    PG8_WAIT_V(0);
    if constexpr (!ALIGN_EPI) { if (wr == 0) PG8_BAR; }
    PG8_BAR;
#undef PG8_SA
#undef PG8_SB
#undef PG8_STAGE
#undef PG8_LDA
#undef PG8_LDB
#undef PG8_MMA
#undef PG8_WAIT_V
#undef PG8_WAIT_L
#undef PG8_BAR
#undef PG8_SCHED
#undef PG8_UA
#undef PG8_UB
}
}

#ifndef PG8_SP2
#define PG8_SP2 true
#endif
#ifndef PG8_ALIGN
#define PG8_ALIGN true
#endif

typedef GAS unsigned gu32;
#define RLX_AGENT __ATOMIC_RELAXED, __HIP_MEMORY_SCOPE_AGENT
#define LDS_WAIT() asm volatile("s_waitcnt lgkmcnt(0)" ::: "memory")
#define VM_WAIT() asm volatile("s_waitcnt vmcnt(0)" ::: "memory")
#define XB_TMO      128
#define XB_XCNT(j)  (256  + 64 * (j))
#define XB_XSUB(j)  (1280 + 64 * (j))
#define XB_XGEN(j)  (2304 + 64 * (j))
#define XB_TOP      3328
#define XB_TOPGEN   3392
#define XCD_BAR_WORDS 3456
#define XB_SPIN_CAP (1u << 22)
__device__ __forceinline__ unsigned xb_ld(unsigned* p)              { return __hip_atomic_load(p, __ATOMIC_RELAXED, __HIP_MEMORY_SCOPE_AGENT); }
__device__ __forceinline__ unsigned xb_add(unsigned* p, unsigned v) { return __hip_atomic_fetch_add(p, v, __ATOMIC_RELAXED, __HIP_MEMORY_SCOPE_AGENT); }
__device__ __forceinline__ unsigned xb_xcc_id() { return (unsigned)__builtin_amdgcn_s_getreg((3 << 11) | 20) & 0xFu; }
#define XB_SPIN(cond, bar) do { unsigned _sp = 0; while (cond) { __builtin_amdgcn_s_sleep(1); \
    if ((++_sp & 255u) == 0u) { if (xb_ld(&(bar)[XB_TMO])) break; if (_sp > XB_SPIN_CAP) { atomicAdd(&(bar)[XB_TMO], 1u); break; } } } } while (0)
struct XcdBarrier { unsigned* bar; unsigned x; volatile LAS unsigned* st; };
__device__ __forceinline__ XcdBarrier xcd_barrier_post(unsigned* bar, volatile LAS unsigned* st) {
    XcdBarrier b; b.bar = bar; b.x = xb_xcc_id(); b.st = st;
    if (threadIdx.x == 0) (void)xb_add(&bar[XB_XCNT(b.x)], 1u);
    return b;
}
__device__ __forceinline__ void xcd_barrier_complete(unsigned* bar, unsigned x, unsigned& nloc, unsigned& nx) {
    const unsigned G = gridDim.x * gridDim.y * gridDim.z;
    unsigned sum, cnt, mine, sp = 0u;
    for (;;) {
        sum = 0u; cnt = 0u; mine = 0u;
#pragma unroll
        for (unsigned j = 0; j < 16; ++j) { const unsigned c = xb_ld(&bar[XB_XCNT(j)]); sum += c; cnt += (c > 0u) ? 1u : 0u; mine = (j == x) ? c : mine; }
        if (sum == G) break;
        __builtin_amdgcn_s_sleep(1);
        if ((++sp & 255u) == 0u) { if (xb_ld(&bar[XB_TMO])) break; if (sp > XB_SPIN_CAP) { atomicAdd(&bar[XB_TMO], 1u); break; } }
    }
    nloc = mine > 0u ? mine : 1u; nx = cnt > 0u ? cnt : 1u;
}
__device__ __forceinline__ void xcd_barrier(const XcdBarrier& b) {
    asm volatile("s_waitcnt vmcnt(0)" ::: "memory");
    __syncthreads();
    if (threadIdx.x == 0) {
        unsigned* bar = b.bar;
        __builtin_amdgcn_s_waitcnt(0);
        unsigned nloc = b.st[0], nx = b.st[1];
        if (nloc == 0u) { xcd_barrier_complete(bar, b.x, nloc, nx); b.st[0] = nloc; b.st[1] = nx; }
        const unsigned old = xb_add(&bar[XB_XSUB(b.x)], 1u);
        const unsigned gen = old / nloc;
        if (old + 1u == (gen + 1u) * nloc) {
            __builtin_amdgcn_fence(__ATOMIC_RELEASE, "agent");
            asm volatile("s_waitcnt vmcnt(0)" ::: "memory");
            const unsigned og = xb_add(&bar[XB_TOP], 1u);
            const unsigned tg = og / nx;
            if (og + 1u == (tg + 1u) * nx) xb_add(&bar[XB_TOPGEN], 1u);
            else XB_SPIN(xb_ld(&bar[XB_TOPGEN]) == tg, bar);
            __builtin_amdgcn_fence(__ATOMIC_ACQUIRE, "agent");
            xb_add(&bar[XB_XGEN(b.x)], 1u);
            asm volatile("s_waitcnt vmcnt(0)" ::: "memory");
        } else {
            XB_SPIN(xb_ld(&bar[XB_XGEN(b.x)]) == gen, bar);
            __builtin_amdgcn_fence(__ATOMIC_ACQUIRE, "agent");
            asm volatile("s_waitcnt vmcnt(0)" ::: "memory");
        }
    }
    __syncthreads();
}

constexpr int NWAVES = 8, NTHREADS = 512;
constexpr int RING_BYTES = 131072, LDSCTL_OFF = RING_BYTES, MISC_OFF = LDSCTL_OFF + 320, LDS_BYTES = 147456;
constexpr int CW_BAR = 4096;

struct Args {
    const float* x_prompt; const float* x_sample; const float* cache_k; const float* cache_v; const float* state_ret;
    const float* norm_gain; const float* final_gain; const float* relb_table; const float* even_w_in; const float* even_w_out;
    const float* sinks; const float* gmlp_ws; const float* gmlp_bs; const float* gmlp_gain; const float* odd_w_in; const float* odd_w_out;
    float* out; unsigned char* ws; int ph_lo, ph_hi;
};

struct EpiEvenIn {
    static constexpr bool PERM = true;
    const float* ss; bf16* ZN; bf16* KN; bf16* VT; bf16* VBT;
    __device__ __forceinline__ void operator()(const f32x4 (&acc)[2][2][4][2], const pg8::Unit& u, int wr, int wc, int fr, int fq) const {
        if (!u.sw) {
            int zc; float mul = 1.f; bool gate = false; const int pn = u.pn;
            if (pn <= 1) { zc = 256 * pn; mul = 0.125f; } else if (pn <= 4) { zc = 512 + 256 * (pn - 3); gate = true; } else if (pn <= 6) { zc = 1024 + 256 * (pn - 5); } else { zc = 1536 + 256 * (pn - 9); gate = true; }
            const int col0 = zc + wc * 32 + 8 * fq;
#pragma unroll
            for (int ai = 0; ai < 2; ++ai)
#pragma unroll
                for (int m = 0; m < 4; ++m) {
                    const int r = u.pm * 256 + ai * 128 + wr * 64 + m * 16 + fr;
                    const float rs = __builtin_amdgcn_rsqf(ss[r] * (1.0f / DM) + EPS) * mul;
#pragma unroll
                    for (int bj = 0; bj < 2; ++bj) {
                        f32x4 v0 = acc[ai][bj][m][0] * rs, v1 = acc[ai][bj][m][1] * rs;
                        if (gate) {
#pragma unroll
                            for (int j = 0; j < 4; ++j) { v0[j] = silu_f(v0[j]); v1[j] = silu_f(v1[j]); }
                        }
                        u32x4 w; w.x = cvt_pk_bf16(v0[0], v0[1]); w.y = cvt_pk_bf16(v0[2], v0[3]); w.z = cvt_pk_bf16(v1[0], v1[1]); w.w = cvt_pk_bf16(v1[2], v1[3]);
                        *(u32x4*)(ZN + (size_t)r * 2048 + col0 + bj * 128) = w;
                    }
                    asm volatile("" ::: "memory");
                }
        } else {
#pragma unroll
            for (int bj = 0; bj < 2; ++bj) {
                const int t0 = u.pm * 256 + bj * 128 + wc * 32 + 8 * fq;
                float rs8[8];
                { const f32x4 s0 = *(const f32x4*)(ss + t0), s1 = *(const f32x4*)(ss + t0 + 4);
#pragma unroll
                  for (int j = 0; j < 4; ++j) { rs8[j] = __builtin_amdgcn_rsqf(s0[j] * (1.0f / DM) + EPS); rs8[4 + j] = __builtin_amdgcn_rsqf(s1[j] * (1.0f / DM) + EPS); } }
#pragma unroll
                for (int ai = 0; ai < 2; ++ai)
#pragma unroll
                    for (int m = 0; m < 4; ++m) {
                        const int zr = ai * 128 + wr * 64 + m * 16 + fr;
                        float v[8];
#pragma unroll
                        for (int j = 0; j < 4; ++j) { v[j] = acc[ai][bj][m][0][j] * rs8[j]; v[4 + j] = acc[ai][bj][m][1][j] * rs8[4 + j]; }
                        if (u.pn == 2) {
                            const int kc = zr & 127;
                            if (ai == 0) {
#pragma unroll
                                for (int j = 0; j < 8; ++j) KN[(size_t)(t0 + j) * 128 + kc] = f2bf(v[j]);
                            } else {
                                u32x4 w; w.x = cvt_pk_bf16(v[0], v[1]); w.y = cvt_pk_bf16(v[2], v[3]); w.z = cvt_pk_bf16(v[4], v[5]); w.w = cvt_pk_bf16(v[6], v[7]);
                                *(u32x4*)(VT + (size_t)kc * M + t0) = w;
                            }
                        } else {
                            const int c = 256 * (u.pn - 7) + zr;
                            u32x4 w; w.x = cvt_pk_bf16(v[0], v[1]); w.y = cvt_pk_bf16(v[2], v[3]); w.z = cvt_pk_bf16(v[4], v[5]); w.w = cvt_pk_bf16(v[6], v[7]);
                            *(u32x4*)(VBT + (size_t)c * M + t0) = w;
                        }
                        asm volatile("" ::: "memory");
                    }
            }
        }
    }
};

struct EpiOddIn {
    static constexpr bool PERM = true;
    const float* ss; const float* sincos; const float* gp; bf16* QN; bf16* KN; bf16* KT; bf16* VT; bf16* GN;
    __device__ __forceinline__ void operator()(const f32x4 (&acc)[2][2][4][2], const pg8::Unit& u, int wr, int wc, int fr, int fq) const {
        const int pn = u.pn;
        if (!u.sw) {
            const bool isq = pn < 4, isk = (pn >= 4 && pn < 8);
            const int h = pn & 3;
#pragma unroll
            for (int ai = 0; ai < 2; ++ai)
#pragma unroll
                for (int m = 0; m < 4; ++m) {
                    const int r = u.pm * 256 + ai * 128 + wr * 64 + m * 16 + fr;
                    float rs = __builtin_amdgcn_rsqf(ss[r] * (1.0f / DM) + EPS);
                    if (isq || isk) {
                        const int pos = r < MP ? (r & (SEQ - 1)) : SEQ + ((r - MP) & 3);
                        float kd = 1.f;
                        if (isk) { rs *= 0.0625f; kd = r < MP ? gp[h * 132 + 127 - (r & 127)] : gp[h * 132 + 3 - ((r - MP) & 3)]; }
#pragma unroll
                        for (int bj = 0; bj < 2; ++bj) {
                            const int d0 = bj * 128 + wc * 32 + 8 * fq;
                            const float* cs = sincos + ((size_t)pos * 128 + (d0 >> 1)) * 2;
                            const f32x4 c0 = *(const f32x4*)cs, c1 = *(const f32x4*)(cs + 4);
                            const f32x4 a0 = acc[ai][bj][m][0] * rs, a1 = acc[ai][bj][m][1] * rs;
                            float v[8];
                            v[0] = a0[0] * c0[0] - a0[1] * c0[1]; v[1] = a0[1] * c0[0] + a0[0] * c0[1];
                            v[2] = a0[2] * c0[2] - a0[3] * c0[3]; v[3] = a0[3] * c0[2] + a0[2] * c0[3];
                            v[4] = a1[0] * c1[0] - a1[1] * c1[1]; v[5] = a1[1] * c1[0] + a1[0] * c1[1];
                            v[6] = a1[2] * c1[2] - a1[3] * c1[3]; v[7] = a1[3] * c1[2] + a1[2] * c1[3];
                            u32x4 w; w.x = cvt_pk_bf16(v[0], v[1]); w.y = cvt_pk_bf16(v[2], v[3]); w.z = cvt_pk_bf16(v[4], v[5]); w.w = cvt_pk_bf16(v[6], v[7]);
                            if (isq) *(u32x4*)(QN + (size_t)r * 1024 + h * 256 + d0) = w;
                            else {
                                *(u32x4*)(KN + (size_t)r * 1024 + h * 256 + d0) = w;
#pragma unroll
                                for (int j = 0; j < 8; ++j) KT[(size_t)(h * 256 + d0 + j) * M + r] = f2bf(v[j] * kd);
                            }
                        }
                    } else {
#pragma unroll
                        for (int bj = 0; bj < 2; ++bj) {
                            f32x4 v0 = acc[ai][bj][m][0] * rs, v1 = acc[ai][bj][m][1] * rs;
#pragma unroll
                            for (int j = 0; j < 4; ++j) { v0[j] = silu_f(v0[j]); v1[j] = silu_f(v1[j]); }
                            u32x4 w; w.x = cvt_pk_bf16(v0[0], v0[1]); w.y = cvt_pk_bf16(v0[2], v0[3]); w.z = cvt_pk_bf16(v1[0], v1[1]); w.w = cvt_pk_bf16(v1[2], v1[3]);
                            *(u32x4*)(GN + (size_t)r * 2048 + (pn - 16) * 256 + bj * 128 + wc * 32 + 8 * fq) = w;
                        }
                    }
                }
        } else {
            float rs8[2][8];
#pragma unroll
            for (int bj = 0; bj < 2; ++bj) {
                const int t0 = u.pm * 256 + bj * 128 + wc * 32 + 8 * fq;
                const f32x4 s0 = *(const f32x4*)(ss + t0), s1 = *(const f32x4*)(ss + t0 + 4);
#pragma unroll
                for (int j = 0; j < 4; ++j) { rs8[bj][j] = __builtin_amdgcn_rsqf(s0[j] * (1.0f / DM) + EPS); rs8[bj][4 + j] = __builtin_amdgcn_rsqf(s1[j] * (1.0f / DM) + EPS); }
            }
#pragma unroll
            for (int ai = 0; ai < 2; ++ai)
#pragma unroll
                for (int m = 0; m < 4; ++m) {
                    const int er = (pn - 8) * 256 + ai * 128 + wr * 64 + m * 16 + fr;
#pragma unroll
                    for (int bj = 0; bj < 2; ++bj) {
                        const int t0 = u.pm * 256 + bj * 128 + wc * 32 + 8 * fq;
                        float v[8];
#pragma unroll
                        for (int j = 0; j < 4; ++j) { v[j] = acc[ai][bj][m][0][j] * rs8[bj][j]; v[4 + j] = acc[ai][bj][m][1][j] * rs8[bj][4 + j]; }
                        u32x4 w; w.x = cvt_pk_bf16(v[0], v[1]); w.y = cvt_pk_bf16(v[2], v[3]); w.z = cvt_pk_bf16(v[4], v[5]); w.w = cvt_pk_bf16(v[6], v[7]);
                        *(u32x4*)(VT + (size_t)er * M + t0) = w;
                    }
                }
        }
    }
};

struct EpiOut {
    static constexpr bool PERM = false;
    const float* base_p; const float* base_s;
    float* X; bf16* XB; float* ssn;
    __device__ __forceinline__ void operator()(const f32x4 (&acc)[2][2][4][2], const pg8::Unit& u, int wr, int wc, int fr, int fq) const {
        const int col0 = u.pn * 256 + wc * 32 + 4 * fq;
#pragma unroll
        for (int ai = 0; ai < 2; ++ai)
#pragma unroll
            for (int m = 0; m < 4; ++m) {
                const int r = u.pm * 256 + ai * 128 + wr * 64 + m * 16 + fr;
                const float* bp = (r < MP ? base_p : base_s) + (size_t)r * DM + col0;
                float sq = 0.f;
#pragma unroll
                for (int bj = 0; bj < 2; ++bj)
#pragma unroll
                    for (int n = 0; n < 2; ++n) {
                        const int co = bj * 128 + n * 16;
                        const f32x4 x = *(const f32x4*)(bp + co) + acc[ai][bj][m][n];
                        *(f32x4*)(X + (size_t)r * DM + col0 + co) = x;
                        u32x2 w; w.x = cvt_pk_bf16(x[0], x[1]); w.y = cvt_pk_bf16(x[2], x[3]);
                        *(u32x2*)(XB + (size_t)r * DM + col0 + co) = w;
                        sq += (x[0] * x[0] + x[1] * x[1]) + (x[2] * x[2] + x[3] * x[3]);
                    }
                sq += __shfl_xor(sq, 16); sq += __shfl_xor(sq, 32);
                if (fq == 0) atomicAdd(ssn + r, sq);
            }
    }
};

template <class T> __device__ __forceinline__ T* rfl_ptr(T* p) {
    const unsigned long long v = (unsigned long long)p;
    const unsigned lo = __builtin_amdgcn_readfirstlane((unsigned)v), hi = __builtin_amdgcn_readfirstlane((unsigned)(v >> 32));
    return (T*)(((unsigned long long)hi << 32) | lo);
}

__device__ __forceinline__ void p0_transpose_item(const float* W, int K, int N, const float* gain, bf16* WT, LAS float* scr, int item, int lane) {
    const int nblk = N / 32, kb = item / nblk, nb = item % nblk, k0 = 64 * kb, n0 = 32 * nb;
#pragma unroll 8
    for (int i = 0; i < 32; ++i) { const int kk = 2 * i + (lane >> 5); float v = W[(size_t)(k0 + kk) * N + n0 + (lane & 31)]; if (gain) v *= gain[k0 + kk]; scr[kk * 33 + (lane & 31)] = v; }
    LDS_WAIT(); asm volatile("" ::: "memory");
    const int c = lane & 7;
#pragma unroll
    for (int j = 0; j < 4; ++j) { const int n = (lane >> 3) + 8 * j; const LAS float* s = scr + (8 * c) * 33 + n;
        u32x4 o; o.x = cvt_pk_bf16(s[0 * 33], s[1 * 33]); o.y = cvt_pk_bf16(s[2 * 33], s[3 * 33]); o.z = cvt_pk_bf16(s[4 * 33], s[5 * 33]); o.w = cvt_pk_bf16(s[6 * 33], s[7 * 33]);
        *(u32x4*)(WT + (size_t)(n0 + n) * K + k0 + 8 * c) = o; }
    LDS_WAIT(); asm volatile("" ::: "memory");
}
__device__ __forceinline__ void sincos_d(double a, float& sn, float& cs) {
    const double kd = __builtin_rint(a * 0.63661977236758134308);
    double t = (a - kd * 1.57079632673412561417e+00) - kd * 6.07710050650619224932e-11;
    const double z = t * t;
    const double ps = -1.66666666666666324348e-01 + z * (8.33333333332248946124e-03 + z * (-1.98412698298579493134e-04 + z * (2.75573137070700676789e-06 + z * (-2.50507602534068634195e-08 + z * 1.58969099521155010221e-10))));
    const double pc = 4.16666666666666019037e-02 + z * (-1.38888888888741095749e-03 + z * (2.48015872894767294178e-05 + z * (-2.75573143513906633035e-07 + z * (2.08757232129817482790e-09 + z * -1.13596475577881948265e-11))));
    const double s = t + t * z * ps, c = 1.0 - 0.5 * z + z * z * pc;
    const int q = ((int)kd) & 3;
    const double so = (q == 0) ? s : (q == 1) ? c : (q == 2) ? -s : -c;
    const double co = (q == 0) ? c : (q == 1) ? -s : (q == 2) ? -c : s;
    sn = (float)so; cs = (float)co;
}
__device__ __forceinline__ void p0_prologue(const LAS Args* AL, LAS unsigned char* lds, int vcu, int G, int wave, int lane) {
    unsigned char* ws = rfl_ptr(((volatile LAS Args*)AL)->ws);
    LAS float* scr = (LAS float*)(lds + wave * 16384);
    const int gw = vcu * NWAVES + wave, NGW = G * NWAVES;
    constexpr int I_EI = 16 * 88, I_EO = 16 * 32, I_OI = 16 * 192, I_OO = 32 * 32;
    constexpr int NIT = 2 * (I_EI + I_EO + I_OI + I_OO);
    for (int it = gw; it < NIT; it += NGW) {
        int r = it;
        if (r < 2 * I_EI) { const int e = r / I_EI; r -= e * I_EI; p0_transpose_item(rfl_ptr(((volatile LAS Args*)AL)->even_w_in) + (size_t)e * 1024 * EVEN_IN, 1024, EVEN_IN, rfl_ptr(((volatile LAS Args*)AL)->norm_gain) + (2 * e) * DM, (bf16*)(ws + WS_WINE) + (size_t)e * EVEN_IN * 1024, scr, r, lane); continue; } r -= 2 * I_EI;
        if (r < 2 * I_EO) { const int e = r / I_EO; r -= e * I_EO; p0_transpose_item(rfl_ptr(((volatile LAS Args*)AL)->even_w_out) + (size_t)e * 1024 * 1024, 1024, 1024, nullptr, (bf16*)(ws + WS_WOUTE) + (size_t)e * 1024 * 1024, scr, r, lane); continue; } r -= 2 * I_EO;
        if (r < 2 * I_OI) { const int o = r / I_OI; r -= o * I_OI; p0_transpose_item(rfl_ptr(((volatile LAS Args*)AL)->odd_w_in) + (size_t)o * 1024 * ODD_IN, 1024, ODD_IN, rfl_ptr(((volatile LAS Args*)AL)->norm_gain) + (2 * o + 1) * DM, (bf16*)(ws + WS_WINO) + (size_t)o * ODD_IN * 1024, scr, r, lane); continue; } r -= 2 * I_OI;
        { const int o = r / I_OO; r -= o * I_OO; p0_transpose_item(rfl_ptr(((volatile LAS Args*)AL)->odd_w_out) + (size_t)o * 2048 * 1024, 2048, 1024, nullptr, (bf16*)(ws + WS_WOUTO) + (size_t)o * 1024 * 2048, scr, r, lane); }
    }
    {
        bf16* XB = (bf16*)(ws + WS_XB); float* ss0 = (float*)(ws + WS_SS);
        for (int m = gw; m < M; m += NGW) {
            const float* xr = m < MP ? rfl_ptr(((volatile LAS Args*)AL)->x_prompt) + (size_t)m * DM : rfl_ptr(((volatile LAS Args*)AL)->x_sample) + (size_t)(m - MP) * DM;
            float s = 0.f;
#pragma unroll
            for (int j = 0; j < 4; ++j) { const f32x4 v = *(const f32x4*)(xr + 256 * j + 4 * lane); s += (v[0] * v[0] + v[1] * v[1]) + (v[2] * v[2] + v[3] * v[3]);
                u32x2 w; w.x = cvt_pk_bf16(v[0], v[1]); w.y = cvt_pk_bf16(v[2], v[3]); *(u32x2*)(XB + (size_t)m * DM + 256 * j + 4 * lane) = w; }
            s = wave_sum(s);
            if (lane == 0) ss0[m] = s;
        }
    }
    {
        float* sc = (float*)(ws + WS_SINCOS);
        const int gt = gw * 64 + lane, NGT = NGW * 64;
        for (int idx = gt; idx < NPOS * 128; idx += NGT) {
            const int pos = idx >> 7, i = idx & 127;
            const float lin = (float)i / 127.0f;
            const float pw = (float)exp((double)lin * 9.210340371976184);
            const float theta = 1.0f / pw;
            const float ang = (float)pos * theta;
            float sn, cs; sincos_d((double)ang, sn, cs);
            *(f32x2*)(sc + (size_t)idx * 2) = (f32x2){cs, sn};
        }
    }
    {
        float* relb = (float*)(ws + WS_TAB + TAB_RELB); float* gp = (float*)(ws + WS_TAB + TAB_GP); bf16* ws16 = (bf16*)(ws + WS_TAB + TAB_WS16);
        const int gt = gw * 64 + lane, NGT = NGW * 64;
        if (gt < 8 * 128) { const int h = gt >> 7, n = gt & 127; int bk;
            if (n < 16) bk = n; else { const float nf = (float)n; int lg = 16 + (int)(logf(nf / 16.0f) / logf(8.0f) * 16.0f); bk = lg < 31 ? lg : 31; }
            relb[h * 128 + n] = rfl_ptr(((volatile LAS Args*)AL)->relb_table)[bk * 8 + h]; }
        if (gt >= 1024 && gt < 1024 + 4) { const int h = gt - 1024; const double gam = 1.0 - exp2(-5.0 - (double)h); double g = 1.0; for (int n = 0; n < 132; ++n) { gp[h * 132 + n] = (float)g; g *= gam; } }
        for (int idx = gt; idx < 2 * 4 * 128 * 128; idx += NGT) { const int q = idx & 127, p = (idx >> 7) & 127; ws16[idx] = q <= p ? f2bf(rfl_ptr(((volatile LAS Args*)AL)->gmlp_ws)[idx]) : (bf16)0; }
    }
}

struct EvenCtx {
    unsigned char* ws; float* out; const float* sinks; const float* ws32; const float* bs; const float* gain; const float* cache_k; const float* cache_v; int e;
};
#define EC_ZN ((const bf16*)(C.ws + WS_Z + ZE_ZN))
#define EC_KN ((const bf16*)(C.ws + WS_Z + ZE_KN))
#define EC_VT ((const bf16*)(C.ws + WS_Z + ZE_VT))
#define EC_VBT ((const bf16*)(C.ws + WS_Z + ZE_VBT))
#define EC_MIX ((bf16*)(C.ws + WS_MIX))
#define EC_RELB ((const float*)(C.ws + WS_TAB + TAB_RELB))
#define EC_WS16 ((const bf16*)(C.ws + WS_TAB + TAB_WS16) + (size_t)C.e * 4 * 128 * 128)
#define EC_OKS (C.out + O_KS + (size_t)C.e * 128 * 128 * 128)
#define EC_OVS (C.out + O_VS + (size_t)C.e * 128 * 128 * 128)
#define EC_OGV (C.out + O_GV + (size_t)C.e * 128 * 4 * 512)
constexpr int RELB_LDS_OFF = 65536;

__device__ __forceinline__ void swa_prompt_item(const EvenCtx& C, int item, LAS unsigned char* lds, int wave, int lane) {
    const int kvh = item & 1, blk = (item >> 1) & 63, b = item >> 7;
    const int g = wave >> 1, half = wave & 1, head = kvh * 4 + g;
    const int fr = lane & 15, fq = lane >> 4;
    const int rowbase = b * SEQ + blk * 128, keybase = rowbase - 128;
    const float sink = C.sinks[head];
    const LAS float* rb = (const LAS float*)(lds + RELB_LDS_OFF) + head * 176 + 16 + fr - 4 * fq;
#pragma unroll 1
    for (int nt = 0; nt < 4; ++nt) {
        const int q0 = 64 * half + 16 * nt;
        const int qtok = rowbase + q0 + fr;
        bf16x8 qf[2];
#pragma unroll
        for (int ks = 0; ks < 2; ++ks) qf[ks] = *(const bf16x8*)(EC_ZN + (size_t)qtok * 2048 + head * 64 + 32 * ks + 8 * fq);
        f32x4 s[9];
#pragma unroll
        for (int r = 0; r < 9; ++r) {
            const int sj0 = q0 + 16 * r;
            const int ktok = (blk == 0 && sj0 < 128) ? rowbase : keybase + sj0;
            const bf16* kp = EC_KN + (size_t)(ktok + fr) * 128 + kvh * 64 + 8 * fq;
            const bf16x8 k0 = *(const bf16x8*)kp, k1 = *(const bf16x8*)(kp + 32);
            f32x4 a = (f32x4){0.f, 0.f, 0.f, 0.f};
            a = MFMA16(k0, qf[0], a); a = MFMA16(k1, qf[1], a);
            s[r] = a;
            if (r % 3 == 2) asm volatile("" ::: "memory");
        }
        float mx = sink;
#pragma unroll
        for (int r = 0; r < 9; ++r)
#pragma unroll
            for (int j = 0; j < 4; ++j) {
                const int dist = fr + 128 - 16 * r - 4 * fq - j;
                const bool valid = (dist >= 0) && (dist < 128) && (blk > 0 || (q0 + 16 * r) >= 128);
                const float v = valid ? s[r][j] + rb[128 - 16 * r - j] : -1e30f;
                s[r][j] = v; mx = fmaxf(mx, v);
            }
        mx = fmaxf(mx, __shfl_xor(mx, 16)); mx = fmaxf(mx, __shfl_xor(mx, 32));
        float sum = 0.f;
#pragma unroll
        for (int r = 0; r < 9; ++r)
#pragma unroll
            for (int j = 0; j < 4; ++j) { const float p = __expf(s[r][j] - mx); s[r][j] = p; sum += p; }
        sum += __shfl_xor(sum, 16); sum += __shfl_xor(sum, 32);
        const float inv = 1.0f / (sum + __expf(sink - mx));
        bf16x8 pf[5];
#pragma unroll
        for (int kp = 0; kp < 5; ++kp) {
            u32x4 w;
            w.x = cvt_pk_bf16(s[2 * kp][0] * inv, s[2 * kp][1] * inv); w.y = cvt_pk_bf16(s[2 * kp][2] * inv, s[2 * kp][3] * inv);
            if (kp < 4) { w.z = cvt_pk_bf16(s[2 * kp + 1][0] * inv, s[2 * kp + 1][1] * inv); w.w = cvt_pk_bf16(s[2 * kp + 1][2] * inv, s[2 * kp + 1][3] * inv); }
            else { w.z = 0u; w.w = 0u; }
            pf[kp] = __builtin_bit_cast(bf16x8, w);
        }
#pragma unroll
        for (int dt = 0; dt < 4; ++dt) {
            f32x4 o = (f32x4){0.f, 0.f, 0.f, 0.f};
            const bf16* vrow = EC_VT + (size_t)(kvh * 64 + 16 * dt + fr) * M;
#pragma unroll
            for (int kp = 0; kp < 5; ++kp) {
                const int r0 = 2 * kp, r1 = kp < 4 ? 2 * kp + 1 : 8;
                const int sj0 = q0 + 16 * r0, sj1 = q0 + 16 * r1;
                const int t0 = (blk == 0 && sj0 < 128) ? rowbase : keybase + sj0;
                const int t1 = (blk == 0 && sj1 < 128) ? rowbase : keybase + sj1;
                const s16x4 lo = *(const s16x4*)(vrow + t0 + 4 * fq), hi = *(const s16x4*)(vrow + t1 + 4 * fq);
                const bf16x8 vf = __builtin_shufflevector(lo, hi, 0, 1, 2, 3, 4, 5, 6, 7);
                o = MFMA16(vf, pf[kp], o);
            }
            const int dc = head * 64 + 16 * dt + 4 * fq;
            const u32x2 gw = *(const u32x2*)(EC_ZN + (size_t)qtok * 2048 + 512 + dc);
            u32x2 w; w.x = cvt_pk_bf16(o[0] * bflo(gw.x), o[1] * bfhi(gw.x)); w.y = cvt_pk_bf16(o[2] * bflo(gw.y), o[3] * bfhi(gw.y));
            *(u32x2*)(EC_MIX + (size_t)qtok * 1024 + dc) = w;
            asm volatile("" ::: "memory");
        }
    }
}

__device__ __forceinline__ void gmlp_prompt_item(const EvenCtx& C, int item, LAS unsigned char* lds, int tid, int wave, int lane) {
    const int tok0 = item * 128;
    LAS float* part = (LAS float*)lds;
    LAS float* mu = part + 1024;
    LAS float* rstd = mu + 128;
    {
        const int tt = tid & 127, qd = tid >> 7; float s = 0.f, s2 = 0.f;
        const bf16* p = EC_VBT + (size_t)(qd * 128) * M + tok0 + tt;
#pragma unroll 8
        for (int c = 0; c < 128; ++c) { const float x = bf2f(p[(size_t)c * M]); s += x; s2 += x * x; }
        part[(qd * 128 + tt) * 2] = s; part[(qd * 128 + tt) * 2 + 1] = s2;
    }
    __syncthreads();
    if (tid < 128) { float s = 0.f, s2 = 0.f;
#pragma unroll
        for (int qd = 0; qd < 4; ++qd) { s += part[(qd * 128 + tid) * 2]; s2 += part[(qd * 128 + tid) * 2 + 1]; }
        const float m = s * (1.0f / 512.0f); const float var = fmaxf(s2 * (1.0f / 512.0f) - m * m, 0.f);
        mu[tid] = m; rstd[tid] = rsqrtf(var + EPS); }
    __syncthreads();
    const int fr = lane & 15, fq = lane >> 4;
    const int g = wave >> 1, cbase = g * 128 + (wave & 1) * 64;
    bf16x8 af[4][4];
#pragma unroll
    for (int mt = 0; mt < 4; ++mt) {
        const int c = cbase + 16 * mt + fr; const float gn = C.gain[c];
#pragma unroll
        for (int ks = 0; ks < 4; ++ks) {
            const int q = 32 * ks + 8 * fq;
            const u32x4 raw = *(const u32x4*)(EC_VBT + (size_t)c * M + tok0 + q);
            const f32x4 m0 = *(const LAS f32x4*)(mu + q), m1 = *(const LAS f32x4*)(mu + q + 4), r0 = *(const LAS f32x4*)(rstd + q), r1 = *(const LAS f32x4*)(rstd + q + 4);
            u32x4 w;
            w.x = cvt_pk_bf16((bflo(raw.x) - m0[0]) * r0[0] * gn, (bfhi(raw.x) - m0[1]) * r0[1] * gn);
            w.y = cvt_pk_bf16((bflo(raw.y) - m0[2]) * r0[2] * gn, (bfhi(raw.y) - m0[3]) * r0[3] * gn);
            w.z = cvt_pk_bf16((bflo(raw.z) - m1[0]) * r1[0] * gn, (bfhi(raw.z) - m1[1]) * r1[1] * gn);
            w.w = cvt_pk_bf16((bflo(raw.w) - m1[2]) * r1[2] * gn, (bfhi(raw.w) - m1[3]) * r1[3] * gn);
            af[mt][ks] = __builtin_bit_cast(bf16x8, w);
        }
    }
    const bf16* wg = EC_WS16 + (size_t)g * 128 * 128;
#pragma unroll 1
    for (int pt = 0; pt < 8; ++pt) {
        f32x4 acc[4];
#pragma unroll
        for (int mt = 0; mt < 4; ++mt) acc[mt] = (f32x4){0.f, 0.f, 0.f, 0.f};
        const int p = 16 * pt + fr;
#pragma unroll
        for (int ks = 0; ks < 4; ++ks) {
            if (32 * ks <= 16 * pt + 15) {
                const bf16x8 bfr = *(const bf16x8*)(wg + (size_t)p * 128 + 32 * ks + 8 * fq);
#pragma unroll
                for (int mt = 0; mt < 4; ++mt) acc[mt] = MFMA16(af[mt][ks], bfr, acc[mt]);
            }
        }
        const float bias = C.bs[g * 128 + p];
        const int tok = tok0 + p;
#pragma unroll
        for (int mt = 0; mt < 4; ++mt) {
            const int c = cbase + 16 * mt + 4 * fq;
            const u32x2 uu = *(const u32x2*)(EC_ZN + (size_t)tok * 2048 + 1024 + c), gb = *(const u32x2*)(EC_ZN + (size_t)tok * 2048 + 1536 + c);
            u32x2 w;
            w.x = cvt_pk_bf16((acc[mt][0] + bias) * bflo(uu.x) * bflo(gb.x), (acc[mt][1] + bias) * bfhi(uu.x) * bfhi(gb.x));
            w.y = cvt_pk_bf16((acc[mt][2] + bias) * bflo(uu.y) * bflo(gb.y), (acc[mt][3] + bias) * bfhi(uu.y) * bfhi(gb.y));
            *(u32x2*)(EC_MIX + (size_t)tok * 1024 + 512 + c) = w;
        }
    }
    __syncthreads();
}

__device__ __forceinline__ void even_sample_item(const EvenCtx& C, int s, LAS unsigned char* lds, int tid, int wave, int lane) {
    const int m0 = MP + 4 * s;
    LAS float* KL = (LAS float*)lds;
    LAS float* QL = KL + 132 * 65;
    LAS float* SL = QL + 16 * 64;
    LAS float* RED = SL + 16 * 132;
    LAS float* ST = RED + 64;
    {
        const f32x4* sk = (const f32x4*)(C.cache_k + ((size_t)s * WIN + DT) * 128); const f32x4* sv = (const f32x4*)(C.cache_v + ((size_t)s * WIN + DT) * 128);
        f32x4* dk = (f32x4*)(EC_OKS + (size_t)s * WIN * 128); f32x4* dv = (f32x4*)(EC_OVS + (size_t)s * WIN * 128);
        for (int i = tid; i < (WIN - DT) * 128 / 4; i += NTHREADS) { dk[i] = sk[i]; dv[i] = sv[i]; }
        { const int t = tid >> 7, c = tid & 127;
          EC_OKS[((size_t)s * WIN + (WIN - DT) + t) * 128 + c] = bf2f(EC_KN[(size_t)(m0 + t) * 128 + c]);
          EC_OVS[((size_t)s * WIN + (WIN - DT) + t) * 128 + c] = bf2f(EC_VT[(size_t)c * M + m0 + t]); }
    }
    for (int kvh = 0; kvh < 2; ++kvh) {
        __syncthreads();
        for (int i = tid; i < 132 * 64; i += NTHREADS) { const int sj = i >> 6, d = i & 63;
            const float v = sj < WIN ? C.cache_k[((size_t)s * WIN + sj) * 128 + kvh * 64 + d] : bf2f(EC_KN[(size_t)(m0 + sj - WIN) * 128 + kvh * 64 + d]);
            KL[sj * 65 + d] = v; }
        for (int i = tid; i < 16 * 64; i += NTHREADS) { const int row = i >> 6, d = i & 63, t = row >> 2, g = row & 3;
            QL[i] = bf2f(EC_ZN[(size_t)(m0 + t) * 2048 + (kvh * 4 + g) * 64 + d]); }
        __syncthreads();
        for (int i = tid; i < 16 * 132; i += NTHREADS) { const int row = i / 132, sj = i - row * 132, t = row >> 2, g = row & 3;
            const int dist = t + WIN - sj; float sc = -1e30f;
            if (dist >= 0 && dist < WIN) { float a = 0.f;
#pragma unroll 16
                for (int d = 0; d < 64; ++d) a += QL[row * 64 + d] * KL[sj * 65 + d];
                sc = a + EC_RELB[(kvh * 4 + g) * 128 + dist]; }
            SL[i] = sc; }
        __syncthreads();
        for (int rr = 0; rr < 2; ++rr) { const int row = 2 * wave + rr, g = row & 3; const float sink = C.sinks[kvh * 4 + g];
            float v0 = SL[row * 132 + lane], v1 = SL[row * 132 + 64 + lane], v2 = lane < 4 ? SL[row * 132 + 128 + lane] : -1e30f;
            float mx = wave_max(fmaxf(fmaxf(v0, v1), v2)); mx = fmaxf(mx, sink);
            v0 = __expf(v0 - mx); v1 = __expf(v1 - mx); v2 = lane < 4 ? __expf(v2 - mx) : 0.f;
            const float inv = 1.0f / (wave_sum(v0 + v1 + v2) + __expf(sink - mx));
            SL[row * 132 + lane] = v0 * inv; SL[row * 132 + 64 + lane] = v1 * inv; if (lane < 4) SL[row * 132 + 128 + lane] = v2 * inv; }
        __syncthreads();
        for (int i = tid; i < 132 * 64; i += NTHREADS) { const int sj = i >> 6, d = i & 63;
            const float v = sj < WIN ? C.cache_v[((size_t)s * WIN + sj) * 128 + kvh * 64 + d] : bf2f(EC_VT[(size_t)(kvh * 64 + d) * M + m0 + sj - WIN]);
            KL[sj * 65 + d] = v; }
        __syncthreads();
        for (int i = tid; i < 16 * 64; i += NTHREADS) { const int row = i >> 6, d = i & 63, t = row >> 2, g = row & 3; float a = 0.f;
            for (int sj = 0; sj < 132; ++sj) a += SL[row * 132 + sj] * KL[sj * 65 + d];
            const int col = (kvh * 4 + g) * 64 + d; const size_t tok = (size_t)(m0 + t);
            EC_MIX[tok * 1024 + col] = f2bf(a * bf2f(EC_ZN[tok * 2048 + 512 + col])); }
    }
    __syncthreads();
    {
        const int c = tid; float x[4];
        const u32x2 raw = *(const u32x2*)(EC_VBT + (size_t)c * M + m0);
        x[0] = bflo(raw.x); x[1] = bfhi(raw.x); x[2] = bflo(raw.y); x[3] = bfhi(raw.y);
#pragma unroll
        for (int t = 0; t < 4; ++t) { const float a = wave_sum(x[t]), b2 = wave_sum(x[t] * x[t]); if (lane == 0) { RED[wave * 8 + t] = a; RED[wave * 8 + 4 + t] = b2; } }
        __syncthreads();
        if (tid < 4) { float a = 0.f, b2 = 0.f; for (int w = 0; w < 8; ++w) { a += RED[w * 8 + tid]; b2 += RED[w * 8 + 4 + tid]; }
            const float m = a * (1.0f / 512.0f), var = fmaxf(b2 * (1.0f / 512.0f) - m * m, 0.f); ST[tid] = m; ST[4 + tid] = rsqrtf(var + EPS); }
        __syncthreads();
        const float gn = C.gain[c]; float vn[4];
#pragma unroll
        for (int t = 0; t < 4; ++t) { vn[t] = (x[t] - ST[t]) * ST[4 + t] * gn; EC_OGV[((size_t)s * 4 + t) * 512 + c] = vn[t]; }
        const int g = c >> 7;
#pragma unroll
        for (int p = 0; p < 4; ++p) { float sv = C.bs[g * 128 + p];
#pragma unroll
            for (int q = 0; q < 4; ++q) if (q <= p) sv += C.ws32[((size_t)g * 128 + p) * 128 + q] * vn[q];
            const size_t tok = (size_t)(m0 + p);
            EC_MIX[tok * 1024 + 512 + c] = f2bf(sv * bf2f(EC_ZN[tok * 2048 + 1024 + c]) * bf2f(EC_ZN[tok * 2048 + 1536 + c])); }
    }
    __syncthreads();
}

struct OddCtx {
    unsigned char* ws; const float* state; float* orp; float* ors;
};
#define OC_QN ((const bf16*)(C.ws + WS_Z + ZO_QN))
#define OC_KN ((const bf16*)(C.ws + WS_Z + ZO_KN))
#define OC_KT ((const bf16*)(C.ws + WS_Z + ZO_KT))
#define OC_VT ((const bf16*)(C.ws + WS_Z + ZO_VT))
#define OC_GN ((const bf16*)(C.ws + WS_Z + ZO_GN))
#define OC_ATT ((bf16*)(C.ws + WS_ATT))
#define OC_OB ((bf16*)(C.ws + WS_OB))
#define OC_MIX ((bf16*)(C.ws + WS_MIX))
#define OC_GP ((const float*)(C.ws + WS_TAB + TAB_GP))
__device__ __forceinline__ void ret_att_item(const OddCtx& C, int item, int wave, int lane) {
    const int c = item & 63, bh = item >> 6, b = bh >> 2, h = bh & 3;
    const int fr = lane & 15, fq = lane >> 4;
    const int tok0 = b * SEQ + c * 128;
    bf16x8 qf[8];
#pragma unroll
    for (int ks = 0; ks < 8; ++ks) qf[ks] = *(const bf16x8*)(OC_QN + (size_t)(tok0 + 16 * wave + fr) * 1024 + h * 256 + 32 * ks + 8 * fq);
    bf16* arow = OC_ATT + ((size_t)item * 128 + 16 * wave + fr) * 128;
    const int i = 16 * wave + fr;
    for (int jt = 0; jt < 8; ++jt) {
        u32x2 w = (u32x2){0u, 0u};
        if (jt <= wave) {
            f32x4 a = (f32x4){0.f, 0.f, 0.f, 0.f};
            const bf16* kp = OC_KN + (size_t)(tok0 + 16 * jt + fr) * 1024 + h * 256 + 8 * fq;
#pragma unroll
            for (int ks = 0; ks < 8; ++ks) a = MFMA16(*(const bf16x8*)(kp + 32 * ks), qf[ks], a);
            float v[4];
#pragma unroll
            for (int j = 0; j < 4; ++j) { const int dj = i - (16 * jt + 4 * fq + j); v[j] = dj >= 0 ? a[j] * OC_GP[h * 132 + dj] : 0.f; }
            w.x = cvt_pk_bf16(v[0], v[1]); w.y = cvt_pk_bf16(v[2], v[3]);
        }
        *(u32x2*)(arow + 16 * jt + 4 * fq) = w;
    }
}
constexpr int ST_PITCH = 528;
__device__ __forceinline__ void ret_scan_block(const OddCtx& C, int bh, int es, LAS unsigned char* lds, int tid, int wave, int lane) {
    const int b = bh >> 2, h = bh & 3, e0 = 32 * es;
    const int fr = lane & 15, fq = lane >> 4;
    for (int i = tid; i < 2 * 32 * ST_PITCH / 4; i += NTHREADS) ((LAS unsigned*)lds)[i] = 0u;
    f32x4 sS[2][2];
#pragma unroll
    for (int dm = 0; dm < 2; ++dm)
#pragma unroll
        for (int en = 0; en < 2; ++en) sS[dm][en] = (f32x4){0.f, 0.f, 0.f, 0.f};
    const float cdec = OC_GP[h * 132 + 128];
    const float qdec = OC_GP[h * 132 + 16 * wave + fr + 1];
    __syncthreads();
    for (int c = 0; c < 64; ++c) {
        const int tok0 = b * SEQ + c * 128;
        LAS unsigned char* rbuf = lds + (c & 1) * (32 * ST_PITCH);
        LAS unsigned char* wbuf = lds + ((c + 1) & 1) * (32 * ST_PITCH);
        bf16x8 vf[2][4], kf[2][4], qf[8], af[4];
#pragma unroll
        for (int en = 0; en < 2; ++en)
#pragma unroll
            for (int ks = 0; ks < 4; ++ks) vf[en][ks] = *(const bf16x8*)(OC_VT + (size_t)(h * 512 + e0 + 16 * en + fr) * M + tok0 + 32 * ks + 8 * fq);
#pragma unroll
        for (int ks = 0; ks < 8; ++ks) qf[ks] = *(const bf16x8*)(OC_QN + (size_t)(tok0 + 16 * wave + fr) * 1024 + h * 256 + 32 * ks + 8 * fq);
#pragma unroll
        for (int ks = 0; ks < 4; ++ks) af[ks] = *(const bf16x8*)(OC_ATT + (((size_t)bh * 64 + c) * 128 + 16 * wave + fr) * 128 + 32 * ks + 8 * fq);
#pragma unroll
        for (int dm = 0; dm < 2; ++dm)
#pragma unroll
            for (int ks = 0; ks < 4; ++ks) kf[dm][ks] = *(const bf16x8*)(OC_KT + (size_t)(h * 256 + 32 * wave + 16 * dm + fr) * M + tok0 + 32 * ks + 8 * fq);
#pragma unroll
        for (int em = 0; em < 2; ++em) {
            f32x4 cr = (f32x4){0.f, 0.f, 0.f, 0.f}, in = (f32x4){0.f, 0.f, 0.f, 0.f};
#pragma unroll
            for (int ks = 0; ks < 8; ++ks) { const bf16x8 sf = *(const LAS bf16x8*)(rbuf + (16 * em + fr) * ST_PITCH + 64 * ks + 16 * fq); cr = MFMA16(sf, qf[ks], cr); }
#pragma unroll
            for (int ks = 0; ks < 4; ++ks) in = MFMA16(vf[em][ks], af[ks], in);
            u32x2 w; w.x = cvt_pk_bf16(in[0] + cr[0] * qdec, in[1] + cr[1] * qdec); w.y = cvt_pk_bf16(in[2] + cr[2] * qdec, in[3] + cr[3] * qdec);
            *(u32x2*)(OC_OB + (size_t)(tok0 + 16 * wave + fr) * 2048 + h * 512 + e0 + 16 * em + 4 * fq) = w;
        }
#pragma unroll
        for (int dm = 0; dm < 2; ++dm)
#pragma unroll
            for (int en = 0; en < 2; ++en) {
                f32x4 a = sS[dm][en] * cdec;
#pragma unroll
                for (int ks = 0; ks < 4; ++ks) a = MFMA16(kf[dm][ks], vf[en][ks], a);
                sS[dm][en] = a;
                u32x2 w; w.x = cvt_pk_bf16(a[0], a[1]); w.y = cvt_pk_bf16(a[2], a[3]);
                *(LAS u32x2*)(wbuf + (16 * en + fr) * ST_PITCH + (32 * wave + 16 * dm + 4 * fq) * 2) = w;
            }
        __syncthreads();
    }
#pragma unroll
    for (int dm = 0; dm < 2; ++dm)
#pragma unroll
        for (int en = 0; en < 2; ++en)
#pragma unroll
            for (int j = 0; j < 4; ++j) C.orp[((size_t)bh * 256 + 32 * wave + 16 * dm + 4 * fq + j) * 512 + e0 + 16 * en + fr] = sS[dm][en][j];
    __syncthreads();
}
__device__ __forceinline__ void ret_sample_item(const OddCtx& C, int item, LAS unsigned char* lds, int tid, int wave, int lane) {
    const int h = item & 3, s = item >> 2, m0 = MP + 4 * s;
    LAS float* QL = (LAS float*)lds;
    LAS float* KD = QL + 1024;
    LAS float* KNL = KD + 1024;
    LAS float* ATL = KNL + 1024;
    LAS float* RED = ATL + 16;
    __syncthreads();
    if (tid < 256) { const int d = tid;
        const u32x2 raw = *(const u32x2*)(OC_KT + (size_t)(h * 256 + d) * M + m0);
        KD[d] = bflo(raw.x); KD[256 + d] = bfhi(raw.x); KD[512 + d] = bflo(raw.y); KD[768 + d] = bfhi(raw.y);
#pragma unroll
        for (int t = 0; t < 4; ++t) { QL[t * 256 + d] = bf2f(OC_QN[(size_t)(m0 + t) * 1024 + h * 256 + d]); KNL[t * 256 + d] = bf2f(OC_KN[(size_t)(m0 + t) * 1024 + h * 256 + d]); }
    }
    __syncthreads();
    if (tid < 16) { const int t = tid >> 2, j = tid & 3; float a = 0.f;
        if (j <= t) { for (int d = 0; d < 256; ++d) a += QL[t * 256 + d] * KNL[j * 256 + d]; a *= OC_GP[h * 132 + (t - j)]; }
        ATL[tid] = a; }
    const int e4 = (tid & 127) * 4, grp = tid >> 7;
    float v[4][4];
#pragma unroll
    for (int j4 = 0; j4 < 4; ++j4) { const u32x2 raw = *(const u32x2*)(OC_VT + (size_t)(h * 512 + e4 + j4) * M + m0);
        v[0][j4] = bflo(raw.x); v[1][j4] = bfhi(raw.x); v[2][j4] = bflo(raw.y); v[3][j4] = bfhi(raw.y); }
    f32x4 cr[4];
#pragma unroll
    for (int t = 0; t < 4; ++t) cr[t] = (f32x4){0.f, 0.f, 0.f, 0.f};
    const float cd4 = OC_GP[h * 132 + 4];
    const float* sp = C.state + ((size_t)s * 4 + h) * 256 * 512 + e4;
    float* op = C.ors + ((size_t)s * 4 + h) * 256 * 512 + e4;
    for (int it0 = 0; it0 < 64; it0 += 8) {
        f32x4 S[8];
#pragma unroll
        for (int u = 0; u < 8; ++u) S[u] = __builtin_nontemporal_load((const f32x4*)(sp + (size_t)(4 * (it0 + u) + grp) * 512));
#pragma unroll
        for (int u = 0; u < 8; ++u) {
            const int d = 4 * (it0 + u) + grp;
            f32x4 sn = S[u] * cd4;
#pragma unroll
            for (int t = 0; t < 4; ++t) { const float q = QL[t * 256 + d], kd = KD[t * 256 + d];
                cr[t] += S[u] * q;
                sn += (f32x4){v[t][0], v[t][1], v[t][2], v[t][3]} * kd; }
            __builtin_nontemporal_store(sn, (f32x4*)(op + (size_t)d * 512));
        }
    }
#pragma unroll
    for (int t = 0; t < 4; ++t) *(LAS f32x4*)(RED + (grp * 4 + t) * 512 + e4) = cr[t];
    __syncthreads();
    {
        const int t = grp;
        f32x4 o = *(LAS f32x4*)(RED + (0 * 4 + t) * 512 + e4) + *(LAS f32x4*)(RED + (1 * 4 + t) * 512 + e4) + *(LAS f32x4*)(RED + (2 * 4 + t) * 512 + e4) + *(LAS f32x4*)(RED + (3 * 4 + t) * 512 + e4);
        o = o * OC_GP[h * 132 + t + 1];
#pragma unroll
        for (int j = 0; j < 4; ++j) { const float a = ATL[t * 4 + j]; o += (f32x4){v[j][0], v[j][1], v[j][2], v[j][3]} * a; }
        u32x2 w; w.x = cvt_pk_bf16(o[0], o[1]); w.y = cvt_pk_bf16(o[2], o[3]);
        *(u32x2*)(OC_OB + (size_t)(m0 + t) * 2048 + h * 512 + e4) = w;
    }
    __syncthreads();
}
__device__ __forceinline__ void ret_norm_rows(const OddCtx& C, int gw, int NGW, int lane) {
    for (int r = gw; r < M; r += NGW) {
#pragma unroll
        for (int hh = 0; hh < 4; ++hh) {
            const size_t off = (size_t)r * 2048 + hh * 512 + 8 * lane;
            const u32x4 raw = *(const u32x4*)(OC_OB + off), gr = *(const u32x4*)(OC_GN + off);
            float x[8]; x[0] = bflo(raw.x); x[1] = bfhi(raw.x); x[2] = bflo(raw.y); x[3] = bfhi(raw.y); x[4] = bflo(raw.z); x[5] = bfhi(raw.z); x[6] = bflo(raw.w); x[7] = bfhi(raw.w);
            float gg[8]; gg[0] = bflo(gr.x); gg[1] = bfhi(gr.x); gg[2] = bflo(gr.y); gg[3] = bfhi(gr.y); gg[4] = bflo(gr.z); gg[5] = bfhi(gr.z); gg[6] = bflo(gr.w); gg[7] = bfhi(gr.w);
            float s = 0.f, s2 = 0.f;
#pragma unroll
            for (int j = 0; j < 8; ++j) { s += x[j]; s2 += x[j] * x[j]; }
            s = wave_sum(s); s2 = wave_sum(s2);
            const float mu = s * (1.0f / 512.0f), var = fmaxf(s2 * (1.0f / 512.0f) - mu * mu, 0.f), rstd = rsqrtf(var + EPS);
            u32x4 w;
            w.x = cvt_pk_bf16((x[0] - mu) * rstd * gg[0], (x[1] - mu) * rstd * gg[1]); w.y = cvt_pk_bf16((x[2] - mu) * rstd * gg[2], (x[3] - mu) * rstd * gg[3]);
            w.z = cvt_pk_bf16((x[4] - mu) * rstd * gg[4], (x[5] - mu) * rstd * gg[5]); w.w = cvt_pk_bf16((x[6] - mu) * rstd * gg[6], (x[7] - mu) * rstd * gg[7]);
            *(u32x4*)(OC_MIX + off) = w;
        }
    }
}

constexpr int N_PHASES = 18;
constexpr int ARGS_OFF = LDSCTL_OFF + 64;
#define ARGP(field) rfl_ptr(((volatile LAS Args*)(lds + ARGS_OFF))->field)
#ifndef PHMASK
#define PHMASK 0x3ffff
#endif
#ifndef E2MASK
#define E2MASK 7
#endif
__global__ void __launch_bounds__(NTHREADS, 2) fwd_kernel(Args A) {
    extern __shared__ __attribute__((aligned(16))) unsigned char lds_raw[];
    LAS unsigned char* lds = (LAS unsigned char*)lds_raw;
    volatile LAS unsigned* MISC = (volatile LAS unsigned*)(lds + MISC_OFF);
    const int tid0 = threadIdx.x;
    const int G = gridDim.x, bx = blockIdx.x;
#define PHASE_IDS() int tid = tid0; asm volatile("" : "+v"(tid)); const int lane = tid & 63, wave = __builtin_amdgcn_readfirstlane(tid >> 6); (void)lane; (void)wave
    const int vcu = (G % 8 == 0) ? (bx % 8) * (G / 8) + bx / 8 : bx;
    for (int u = tid0; u < (LDS_BYTES - LDSCTL_OFF) / 4; u += NTHREADS) ((LAS unsigned*)(lds + LDSCTL_OFF))[u] = 0u;
    __syncthreads();
    if (tid0 == 0) { Args* dst = (Args*)(lds_raw + ARGS_OFF); *dst = A; }
    const int lo = A.ph_lo, hi = A.ph_hi;
    __syncthreads();
    const bool use_bar = (hi - lo) > 1;
    XcdBarrier bar; bar.bar = (unsigned*)(ARGP(ws) + WS_CTL) + CW_BAR; bar.x = 0; bar.st = nullptr;
    if (use_bar) bar = xcd_barrier_post(bar.bar, MISC + 8);
#define IN(k) (((PHMASK >> (k)) & 1) && lo <= (k) && (k) < hi)
#define SEAM(k) do { if (lo <= (k) && (k) + 1 < hi) xcd_barrier(bar); } while (0)

    if (IN(0)) { PHASE_IDS(); p0_prologue((const LAS Args*)(lds + ARGS_OFF), lds, vcu, G, wave, lane); }
    SEAM(0);
#pragma unroll 1
    for (int layer = 0; layer < 4; ++layer) {
        const int e = layer >> 1;
        if ((layer & 1) == 0) {
            const int p0 = layer == 0 ? 1 : 9;
            if (IN(p0)) {
                unsigned char* ws = ARGP(ws);
                pg8::Gemm g{(const bf16*)(ws + WS_XB), (const bf16*)(ws + WS_WINE) + (size_t)e * EVEN_IN * 1024, M, EVEN_IN, 1024};
                pg8::StaticOrder S; S.init(M, EVEN_IN, G, bx, (1u << 2) | (1u << 7) | (1u << 8));
                EpiEvenIn E{(const float*)(ws + WS_SS) + (size_t)layer * M, (bf16*)(ws + WS_Z + ZE_ZN), (bf16*)(ws + WS_Z + ZE_KN), (bf16*)(ws + WS_Z + ZE_VT), (bf16*)(ws + WS_Z + ZE_VBT)};
                pg8::gemm_phase<EpiEvenIn, pg8::StaticOrder, PG8_ALIGN, PG8_SP2>(lds, g, S, E);
            }
            SEAM(p0);
            if (IN(p0 + 1)) {
                PHASE_IDS();
                EvenCtx C{ARGP(ws), ARGP(out), ARGP(sinks) + e * 8, ARGP(gmlp_ws) + (size_t)e * 4 * 128 * 128, ARGP(gmlp_bs) + e * 4 * 128, ARGP(gmlp_gain) + e * 512,
                          ARGP(cache_k) + (size_t)e * 128 * 128 * 128, ARGP(cache_v) + (size_t)e * 128 * 128 * 128, e};
                for (int i = tid; i < 8 * 176; i += NTHREADS) { const int hh = i / 176, dd = i - hh * 176 - 16; ((LAS float*)(lds + RELB_LDS_OFF))[i] = EC_RELB[hh * 128 + (dd < 0 ? 0 : (dd > 127 ? 127 : dd))]; }
                __syncthreads();
                if (E2MASK & 1) {
#pragma unroll 1
                    for (int it = bx; it < 256; it += G) swa_prompt_item(C, it, lds, wave, lane); }
#pragma unroll 1
                for (int it = bx; it < 256; it += G) { if (it < 128) { if (E2MASK & 2) gmlp_prompt_item(C, it, lds, tid, wave, lane); } else { if (E2MASK & 4) even_sample_item(C, it - 128, lds, tid, wave, lane); } }
                { float* okp = C.out + O_KP + (size_t)e * 2 * 128 * 128; float* ovp = C.out + O_VP + (size_t)e * 2 * 128 * 128;
                  for (int i = bx * NTHREADS + tid; i < 2 * 128 * 128; i += G * NTHREADS) { const int c = i & 127, w = (i >> 7) & 127, b = i >> 14; const int tok = b * SEQ + SEQ - WIN + w;
                      okp[i] = bf2f(EC_KN[(size_t)tok * 128 + c]); ovp[i] = bf2f(EC_VT[(size_t)c * M + tok]); } }
            }
            SEAM(p0 + 1);
            if (IN(p0 + 2)) {
                unsigned char* ws = ARGP(ws); float* out = ARGP(out);
                pg8::Gemm g{(const bf16*)(ws + WS_MIX), (const bf16*)(ws + WS_WOUTE) + (size_t)e * 1024 * 1024, M, 1024, 1024};
                pg8::StaticOrder S; S.init(M, 1024, G, bx, 0u);
                EpiOut E{layer == 0 ? ARGP(x_prompt) : out, layer == 0 ? ARGP(x_sample) - (size_t)MP * DM : out, out, (bf16*)(ws + WS_XB), (float*)(ws + WS_SS) + (size_t)(layer + 1) * M};
                pg8::gemm_phase<EpiOut, pg8::StaticOrder, PG8_ALIGN, PG8_SP2>(lds, g, S, E);
            }
            SEAM(p0 + 2);
        } else {
            const int p0 = layer == 1 ? 4 : 12;
            if (IN(p0)) {
                unsigned char* ws = ARGP(ws);
                pg8::Gemm g{(const bf16*)(ws + WS_XB), (const bf16*)(ws + WS_WINO) + (size_t)e * ODD_IN * 1024, M, ODD_IN, 1024};
                pg8::StaticOrder S; S.init(M, ODD_IN, G, bx, 0x0000ff00u);
                EpiOddIn E{(const float*)(ws + WS_SS) + (size_t)layer * M, (const float*)(ws + WS_SINCOS), (const float*)(ws + WS_TAB + TAB_GP), (bf16*)(ws + WS_Z + ZO_QN), (bf16*)(ws + WS_Z + ZO_KN), (bf16*)(ws + WS_Z + ZO_KT), (bf16*)(ws + WS_Z + ZO_VT), (bf16*)(ws + WS_Z + ZO_GN)};
                pg8::gemm_phase<EpiOddIn, pg8::StaticOrder, PG8_ALIGN, PG8_SP2>(lds, g, S, E);
            }
            SEAM(p0);
            if (IN(p0 + 1)) {
                PHASE_IDS();
                OddCtx C{ARGP(ws), nullptr, nullptr, nullptr};
#pragma unroll 1
                for (int it = bx; it < 512; it += G) ret_att_item(C, it, wave, lane);
            }
            SEAM(p0 + 1);
            if (IN(p0 + 2)) {
                PHASE_IDS();
                float* out = ARGP(out);
                OddCtx C{ARGP(ws), ARGP(state_ret) + (size_t)e * 128 * 4 * 256 * 512, out + O_RP + (size_t)e * 2 * 4 * 256 * 512, out + O_RS + (size_t)e * 128 * 4 * 256 * 512};
                const int nscan = G >= 256 ? 128 : G / 2;
                if (bx < nscan) {
#pragma unroll 1
                    for (int it = bx; it < 128; it += nscan) ret_scan_block(C, it & 7, it >> 3, lds, tid, wave, lane); }
                else {
#pragma unroll 1
                    for (int it = bx - nscan; it < 512; it += G - nscan) ret_sample_item(C, it, lds, tid, wave, lane); }
            }
            SEAM(p0 + 2);
            if (IN(p0 + 3)) { PHASE_IDS(); OddCtx C{ARGP(ws), nullptr, nullptr, nullptr}; ret_norm_rows(C, vcu * NWAVES + wave, G * NWAVES, lane); }
            SEAM(p0 + 3);
            if (IN(p0 + 4)) {
                unsigned char* ws = ARGP(ws); float* out = ARGP(out);
                pg8::Gemm g{(const bf16*)(ws + WS_MIX), (const bf16*)(ws + WS_WOUTO) + (size_t)e * 1024 * 2048, M, 1024, 2048};
                pg8::StaticOrder S; S.init(M, 1024, G, bx, 0u);
                EpiOut E{out, out, out, (bf16*)(ws + WS_XB), (float*)(ws + WS_SS) + (size_t)(layer + 1) * M};
                pg8::gemm_phase<EpiOut, pg8::StaticOrder, PG8_ALIGN, PG8_SP2>(lds, g, S, E);
            }
            SEAM(p0 + 4);
        }
    }
    if (IN(17)) {
        PHASE_IDS();
        unsigned char* ws = ARGP(ws); float* out = ARGP(out); const float* fg = ARGP(final_gain);
        const float* ss = (const float*)(ws + WS_SS) + (size_t)4 * M;
        for (int r = vcu * NWAVES + wave; r < M; r += G * NWAVES) {
            const float rs = rsqrtf(ss[r] * (1.0f / DM) + EPS);
#pragma unroll
            for (int j = 0; j < 4; ++j) { f32x4* p = (f32x4*)(out + (size_t)r * DM + 256 * j + 4 * lane); const f32x4 gg = *(const f32x4*)(fg + 256 * j + 4 * lane); *p = *p * rs * gg; }
        }
    }
#undef IN
#undef SEAM
}

extern "C" void kernel_launch(void* const* d_in, const int* in_sizes, int n_in, void* d_out, int out_size, void* d_ws, size_t ws_size, hipStream_t stream) {
    static int grid = 0;
    if (grid == 0) {
        if (n_in != 16 || (size_t)out_size != O_END || ws_size < WS_END) { fprintf(stderr, "kernel_launch: unexpected sizes n_in %d out %d ws %zu (need %zu / %zu)\n", n_in, out_size, ws_size, (size_t)O_END, (size_t)WS_END); grid = -1; return; }
        int dev = 0, cus = 0, per_cu = 0;
        if (hipGetDevice(&dev) != hipSuccess || hipDeviceGetAttribute(&cus, hipDeviceAttributeMultiprocessorCount, dev) != hipSuccess) { grid = -1; return; }
        if (hipFuncSetAttribute((const void*)fwd_kernel, hipFuncAttributeMaxDynamicSharedMemorySize, LDS_BYTES) != hipSuccess) { fprintf(stderr, "kernel_launch: hipFuncSetAttribute failed\n"); grid = -1; return; }
        if (hipOccupancyMaxActiveBlocksPerMultiprocessor(&per_cu, (const void*)fwd_kernel, NTHREADS, LDS_BYTES) != hipSuccess || per_cu < 1) { fprintf(stderr, "kernel_launch: occupancy query says %d\n", per_cu); per_cu = 1; }
        (void)hipGetLastError();
        grid = cus;
        if (grid > 256) grid = 256;
        grid &= ~7;
    }
    if (grid <= 0) return;
    (void)hipMemsetAsync((char*)d_ws + WS_CTL, 0, CTL_ZERO_BYTES, stream);
    Args a{};
    a.x_prompt = (const float*)d_in[0]; a.x_sample = (const float*)d_in[1]; a.cache_k = (const float*)d_in[2]; a.cache_v = (const float*)d_in[3]; a.state_ret = (const float*)d_in[4];
    a.norm_gain = (const float*)d_in[5]; a.final_gain = (const float*)d_in[6]; a.relb_table = (const float*)d_in[7]; a.even_w_in = (const float*)d_in[8]; a.even_w_out = (const float*)d_in[9];
    a.sinks = (const float*)d_in[10]; a.gmlp_ws = (const float*)d_in[11]; a.gmlp_bs = (const float*)d_in[12]; a.gmlp_gain = (const float*)d_in[13]; a.odd_w_in = (const float*)d_in[14]; a.odd_w_out = (const float*)d_in[15];
    a.out = (float*)d_out; a.ws = (unsigned char*)d_ws;
#if MK_ONE_LAUNCH
    a.ph_lo = 0; a.ph_hi = N_PHASES;
    hipLaunchKernelGGL(fwd_kernel, dim3(grid), dim3(NTHREADS), LDS_BYTES, stream, a);
#else
    for (int p = 0; p < N_PHASES; ++p) { a.ph_lo = p; a.ph_hi = p + 1; hipLaunchKernelGGL(fwd_kernel, dim3(grid), dim3(NTHREADS), LDS_BYTES, stream, a); }
#endif
}
```
